# Optimizing an MI355X kernel written in HIP

```python
import math
import jax
import jax.numpy as jnp
from jax import lax
import numpy as np

D_MODEL = 1024
BATCH = 1
SEQ = 16384
DEPTH = 1
DEC_BATCH = 32
DEC_SEQ = 32
PAST_LEN = 4096

CHUNK = 64
N_META = 16
META_PAD = CHUNK - N_META
DN_HEADS = 8
DN_DK = 64
DN_DV = 64
DN_QK = DN_HEADS * DN_DK
DN_V = DN_HEADS * DN_DV
CONV_W = 4
CONV_CH = 2 * DN_QK + DN_V
SWA_HEADS = 8
SWA_KV = 2
SWA_G = SWA_HEADS // SWA_KV
SWA_HD = 64
WINDOW = 128
WIN_CHUNKS = WINDOW // CHUNK
N_BUCKETS = 32
MAX_DIST = 128
D_FF = 4 * D_MODEL
MIX_WIDTH = DN_V + SWA_HEADS * SWA_HD
OFF_Z = CONV_CH
OFF_A = OFF_Z + DN_V
OFF_B = OFF_A + DN_HEADS
OFF_SQ = OFF_B + DN_HEADS
OFF_SK = OFF_SQ + SWA_HEADS * SWA_HD
OFF_SV = OFF_SK + SWA_KV * SWA_HD
PROJ_WIDTH = OFF_SV + SWA_KV * SWA_HD
DEEP_ALPHA = (2 * DEPTH) ** 0.25
DEEP_BETA = (8 * DEPTH) ** -0.25
LN_EPS = 1e-5
NORM_EPS = 1e-6

kernel_name = 'hybrid_deltanet_swa_streaming_step'


def layer_norm(x, g, b):
    xf = x.astype(jnp.float32)
    mu = jnp.mean(xf, -1, keepdims=True)
    var = jnp.mean(jnp.square(xf - mu), -1, keepdims=True)
    return ((xf - mu) * lax.rsqrt(var + LN_EPS) * g.astype(jnp.float32) + b.astype(jnp.float32)).astype(x.dtype)


def l2_normalize(x):
    return x * lax.rsqrt(jnp.sum(jnp.square(x), -1, keepdims=True) + NORM_EPS)


def t5_bucket(rel):
    half = N_BUCKETS // 2
    max_exact = half // 2
    n = jnp.abs(rel)
    large = max_exact + (jnp.log(jnp.maximum(n, 1).astype(jnp.float32) / max_exact)
                         / math.log(MAX_DIST / max_exact) * (half - max_exact)).astype(jnp.int32)
    large = jnp.minimum(large, half - 1)
    return jnp.where(rel > 0, half, 0) + jnp.where(n < max_exact, n, large)


def rel_bias(table, n_q, n_k, key_offset):
    rel = (jnp.arange(n_k)[None, :] - key_offset) - jnp.arange(n_q)[:, None]
    b = table.astype(jnp.float32)[t5_bucket(rel)]
    return b.reshape(n_q, n_k, SWA_KV, SWA_G).transpose(2, 3, 0, 1)


def short_conv(x, buf, w):
    L = x.shape[1]
    xp = jnp.concatenate([buf.astype(x.dtype), x], axis=1)
    y = sum(xp[:, j:j + L] * w[j] for j in range(CONV_W))
    return jax.nn.silu(y), xp[:, -(CONV_W - 1):]


def gated_delta_rule(q, k, v, g, beta, S0, chunk):
    B, L, H, DK = q.shape
    DV = v.shape[-1]
    n = L // chunk

    def blk(t):
        return jnp.moveaxis(t.reshape((B, n, chunk, H) + t.shape[3:]), 3, 1)

    q, k, v, g, beta = blk(q), blk(k), blk(v), blk(g), blk(beta)
    G = jnp.cumsum(g, axis=-1)
    idx = jnp.arange(chunk)
    causal = idx[:, None] >= idx[None, :]
    strict = idx[:, None] > idx[None, :]
    decay = jnp.exp(jnp.where(causal, G[..., :, None] - G[..., None, :], -jnp.inf))
    kk = jnp.einsum('bhnid,bhnjd->bhnij', k, k)
    A = jnp.where(strict, beta[..., :, None] * kk * decay, 0.0)
    T = A + jnp.eye(chunk, dtype=A.dtype)
    W = lax.linalg.triangular_solve(T, (beta * jnp.exp(G))[..., None] * k,
                                    left_side=True, lower=True, unit_diagonal=True)
    U = lax.linalg.triangular_solve(T, beta[..., None] * v,
                                    left_side=True, lower=True, unit_diagonal=True)
    qk = jnp.einsum('bhnid,bhnjd->bhnij', q, k) * decay
    q_dec = q * jnp.exp(G)[..., None]
    k_dec = k * jnp.exp(G[..., -1:] - G)[..., None]
    g_tot = jnp.exp(G[..., -1])

    def step(S, xs):
        W_c, U_c, qk_c, qd_c, kd_c, gt_c = xs
        u = U_c - jnp.einsum('bhck,bhkv->bhcv', W_c, S)
        o = jnp.einsum('bhck,bhkv->bhcv', qd_c, S) + jnp.einsum('bhij,bhjv->bhiv', qk_c, u)
        S = gt_c[..., None, None] * S + jnp.einsum('bhck,bhcv->bhkv', kd_c, u)
        return S, o

    xs = tuple(jnp.moveaxis(t, 2, 0) for t in (W, U, qk, q_dec, k_dec, g_tot))
    S, o = lax.scan(step, S0, xs)
    o = jnp.moveaxis(jnp.moveaxis(o, 0, 2), 1, 3).reshape(B, L, H, DV)
    return o, S


def deltanet_mixer(proj, conv_buf, S0, w_conv, a_log, dt_bias, norm_w, front_pad, chunk):
    B, L, _ = proj.shape
    f32 = jnp.float32
    qkv, conv_state = short_conv(proj[..., :CONV_CH], conv_buf, w_conv)
    qkv = qkv.astype(f32)
    q = l2_normalize(qkv[..., :DN_QK].reshape(B, L, DN_HEADS, DN_DK)) * DN_DK ** -0.5
    k = l2_normalize(qkv[..., DN_QK:2 * DN_QK].reshape(B, L, DN_HEADS, DN_DK))
    v = qkv[..., 2 * DN_QK:].reshape(B, L, DN_HEADS, DN_DV)
    a = proj[..., OFF_A:OFF_B].astype(f32)
    b = proj[..., OFF_B:OFF_SQ].astype(f32)
    g = -jnp.exp(a_log.astype(f32)) * jax.nn.softplus(a + dt_bias.astype(f32))
    beta = jax.nn.sigmoid(b)

    def pad(t):
        return jnp.pad(t, ((0, 0), (front_pad, 0)) + ((0, 0),) * (t.ndim - 2))

    o, S = gated_delta_rule(pad(q), pad(k), pad(v), pad(g), pad(beta), S0.astype(f32), chunk)
    o = o[:, front_pad:]
    z = proj[..., OFF_Z:OFF_A].astype(f32).reshape(B, L, DN_HEADS, DN_DV)
    o = o * lax.rsqrt(jnp.mean(jnp.square(o), -1, keepdims=True) + NORM_EPS) \
        * norm_w.astype(f32) * jax.nn.silu(z)
    return o.reshape(B, L, DN_V).astype(proj.dtype), conv_state, S.astype(S0.dtype)


def sink_attention(q, k, v, bias, key_valid, sinks):
    s = jnp.einsum('bnqhgd,bnshd->bnhgqs', q, k).astype(jnp.float32) * SWA_HD ** -0.5 + bias
    s = jnp.where(key_valid[None, :, None, None, None, :], s, -jnp.inf)
    sink = jnp.broadcast_to(sinks.astype(jnp.float32).reshape(SWA_KV, SWA_G)[None, None, :, :, None, None],
                            s.shape[:-1] + (1,))
    p = jax.nn.softmax(jnp.concatenate([s, sink], axis=-1), axis=-1)[..., :-1]
    return jnp.einsum('bnhgqs,bnshd->bnqhgd', p.astype(v.dtype), v)


def swa_prompt(proj, bias, key_valid, sinks):
    B, Lr, _ = proj.shape
    L = Lr + META_PAD
    n = L // CHUNK
    span = WIN_CHUNKS * CHUNK
    q = jnp.pad(proj[..., OFF_SQ:OFF_SK], ((0, 0), (META_PAD, 0), (0, 0)))
    q = q.reshape(B, n, CHUNK, SWA_KV, SWA_G, SWA_HD)
    k = proj[..., OFF_SK:OFF_SV].reshape(B, Lr, SWA_KV, SWA_HD)
    v = proj[..., OFF_SV:PROJ_WIDTH].reshape(B, Lr, SWA_KV, SWA_HD)
    pads = ((0, 0), (META_PAD + span, 0), (0, 0), (0, 0))
    kp, vp = jnp.pad(k, pads), jnp.pad(v, pads)
    kb = jnp.concatenate([kp[:, j * CHUNK:j * CHUNK + L].reshape(B, n, CHUNK, SWA_KV, SWA_HD)
                          for j in range(WIN_CHUNKS + 1)], axis=2)
    vb = jnp.concatenate([vp[:, j * CHUNK:j * CHUNK + L].reshape(B, n, CHUNK, SWA_KV, SWA_HD)
                          for j in range(WIN_CHUNKS + 1)], axis=2)
    o = sink_attention(q, kb, vb, bias, key_valid, sinks).reshape(B, L, SWA_HEADS * SWA_HD)
    return o[:, META_PAD:], k[:, -WINDOW:], v[:, -WINDOW:]


def swa_sample(proj, cache_k, cache_v, bias, sinks):
    B, D, _ = proj.shape
    q = proj[..., OFF_SQ:OFF_SK].reshape(B, 1, D, SWA_KV, SWA_G, SWA_HD)
    k = proj[..., OFF_SK:OFF_SV].reshape(B, D, SWA_KV, SWA_HD)
    v = proj[..., OFF_SV:PROJ_WIDTH].reshape(B, D, SWA_KV, SWA_HD)
    kb = jnp.concatenate([cache_k.astype(k.dtype), k], axis=1)[:, None]
    vb = jnp.concatenate([cache_v.astype(v.dtype), v], axis=1)[:, None]
    valid = jnp.ones((1, kb.shape[2]), bool)
    o = sink_attention(q, kb, vb, bias, valid, sinks)
    return o.reshape(B, D, SWA_HEADS * SWA_HD), k, v


def post_sublayers(h, mix, w_o, ln1_g, ln1_b, w_ff1, w_ff2, ln2_g, ln2_b):
    h = layer_norm(DEEP_ALPHA * h + mix @ w_o, ln1_g, ln1_b)
    f = jnp.square(jax.nn.relu(h @ w_ff1)) @ w_ff2
    return layer_norm(DEEP_ALPHA * h + f, ln2_g, ln2_b)


def setup_inputs(seed: int = 0) -> dict:
    key = jax.random.key(seed)
    ks = jax.random.split(key, 24)
    f32 = jnp.float32

    def nrm(k, shape, s):
        return jax.random.normal(k, shape, f32) * s

    cache_len = min(WINDOW, PAST_LEN)
    dt = jnp.exp(jax.random.uniform(ks[10], (DEPTH, DN_HEADS), f32, math.log(1e-3), math.log(1e-1)))
    return {
        'x_prompt': nrm(ks[0], (BATCH, SEQ, D_MODEL), 1.0),
        'x_sample': nrm(ks[1], (DEC_BATCH, DEC_SEQ, D_MODEL), 1.0),
        'state_delta': nrm(ks[2], (DEPTH, DEC_BATCH, DN_HEADS, DN_DK, DN_DV), 0.125),
        'state_conv': nrm(ks[3], (DEPTH, DEC_BATCH, CONV_W - 1, CONV_CH), 1.0),
        'cache_swa_k': nrm(ks[4], (DEPTH, DEC_BATCH, cache_len, SWA_KV, SWA_HD), 1.0),
        'cache_swa_v': nrm(ks[5], (DEPTH, DEC_BATCH, cache_len, SWA_KV, SWA_HD), 1.0),
        'meta_tokens': nrm(ks[6], (N_META, D_MODEL), 1.0),
        'ln_in_g': 1.0 + nrm(ks[7], (D_MODEL,), 0.02),
        'ln_in_b': nrm(ks[8], (D_MODEL,), 0.02),
        'w_in': nrm(ks[9], (DEPTH, D_MODEL, PROJ_WIDTH), D_MODEL ** -0.5),
        'w_conv': nrm(ks[11], (DEPTH, CONV_W, CONV_CH), CONV_W ** -0.5),
        'dn_a_log': jnp.log(jax.random.uniform(ks[12], (DEPTH, DN_HEADS), f32, 1.0, 16.0)),
        'dn_dt_bias': dt + jnp.log(-jnp.expm1(-dt)),
        'dn_norm': 1.0 + nrm(ks[13], (DEPTH, DN_DV), 0.02),
        'swa_sinks': nrm(ks[14], (DEPTH, SWA_HEADS), 0.5),
        'rel_bias_table': nrm(ks[15], (N_BUCKETS, SWA_HEADS), 0.5),
        'w_o': nrm(ks[16], (DEPTH, MIX_WIDTH, D_MODEL), MIX_WIDTH ** -0.5 * DEEP_BETA),
        'ln1_g': 1.0 + nrm(ks[17], (DEPTH, D_MODEL), 0.02),
        'ln1_b': nrm(ks[18], (DEPTH, D_MODEL), 0.02),
        'w_ff1': nrm(ks[19], (DEPTH, D_MODEL, D_FF), D_MODEL ** -0.5),
        'w_ff2': nrm(ks[20], (DEPTH, D_FF, D_MODEL), D_FF ** -0.5 * DEEP_BETA),
        'ln2_g': 1.0 + nrm(ks[21], (DEPTH, D_MODEL), 0.02),
        'ln2_b': nrm(ks[22], (DEPTH, D_MODEL), 0.02),
    }


def reference(x_prompt, x_sample, state_delta, state_conv, cache_swa_k, cache_swa_v,
              meta_tokens, ln_in_g, ln_in_b, w_in, w_conv, dn_a_log, dn_dt_bias, dn_norm,
              swa_sinks, rel_bias_table, w_o, ln1_g, ln1_b, w_ff1, w_ff2, ln2_g, ln2_b):
    B = x_prompt.shape[0]
    D = x_sample.shape[1]
    Wc = cache_swa_k.shape[2]
    span = WIN_CHUNKS * CHUNK
    meta = jnp.broadcast_to(meta_tokens.astype(x_prompt.dtype)[None], (B, N_META, D_MODEL))
    hp = layer_norm(jnp.concatenate([meta, x_prompt], axis=1), ln_in_g, ln_in_b)
    hs = layer_norm(x_sample, ln_in_g, ln_in_b)
    n_blk = (hp.shape[1] + META_PAD) // CHUNK
    key_idx = jnp.arange(n_blk)[:, None] * CHUNK + jnp.arange(span + CHUNK)[None, :] - span
    prompt_key_valid = key_idx >= META_PAD
    bias_prompt = rel_bias(rel_bias_table, CHUNK, span + CHUNK, span)
    bias_sample = rel_bias(rel_bias_table, D, Wc + D, Wc)
    zero_conv = jnp.zeros((B, CONV_W - 1, CONV_CH), state_conv.dtype)
    zero_S = jnp.zeros((B, DN_HEADS, DN_DK, DN_DV), state_delta.dtype)
    p_S, p_conv, p_k, p_v, s_S, s_conv, s_k, s_v = [], [], [], [], [], [], [], []
    for l in range(DEPTH):
        proj = hp @ w_in[l]
        dn_o, conv_new, S_new = deltanet_mixer(proj, zero_conv, zero_S, w_conv[l], dn_a_log[l],
                                               dn_dt_bias[l], dn_norm[l], META_PAD, CHUNK)
        sw_o, k_rows, v_rows = swa_prompt(proj, bias_prompt, prompt_key_valid, swa_sinks[l])
        hp = post_sublayers(hp, jnp.concatenate([dn_o, sw_o], axis=-1), w_o[l],
                            ln1_g[l], ln1_b[l], w_ff1[l], w_ff2[l], ln2_g[l], ln2_b[l])
        p_S.append(S_new); p_conv.append(conv_new); p_k.append(k_rows); p_v.append(v_rows)
        proj = hs @ w_in[l]
        dn_o, conv_new, S_new = deltanet_mixer(proj, state_conv[l], state_delta[l], w_conv[l], dn_a_log[l],
                                               dn_dt_bias[l], dn_norm[l], 0, D)
        sw_o, k_rows, v_rows = swa_sample(proj, cache_swa_k[l], cache_swa_v[l], bias_sample, swa_sinks[l])
        hs = post_sublayers(hs, jnp.concatenate([dn_o, sw_o], axis=-1), w_o[l],
                            ln1_g[l], ln1_b[l], w_ff1[l], w_ff2[l], ln2_g[l], ln2_b[l])
        s_S.append(S_new); s_conv.append(conv_new); s_k.append(k_rows); s_v.append(v_rows)
    y_prompt = hp[:, N_META:]
    y_sample = hs
    return (y_prompt, y_sample, jnp.stack(p_S), jnp.stack(p_conv), jnp.stack(p_k), jnp.stack(p_v),
            jnp.stack(s_S), jnp.stack(s_conv), jnp.stack(s_k), jnp.stack(s_v))
```

```cpp
#include <hip/hip_runtime.h>
#include <cstdio>
#include <cstdint>
#define MK_N_LAUNCHES 1
#include <cmath>
namespace pg8 {
#define PG8_LAS __attribute__((address_space(3)))
typedef unsigned short bf16_t;
typedef short bf16x8 __attribute__((ext_vector_type(8)));
typedef float f32x4 __attribute__((ext_vector_type(4)));
typedef unsigned u32x4 __attribute__((ext_vector_type(4)));
constexpr int BM = 256, BK = 64, HALF = 128, HTB = HALF * BK * 2  , STAGE_BYTES = 8 * HTB, NXCD = 8, WGM = 8;

__host__ __device__ __forceinline__ int lds_byte(int r, int c) { const int st = (r >> 4) * 2 + (c >> 5), rr = r & 15, cc = c & 31, ob = rr * 64 + cc * 2; return st * 1024 + (ob ^ (((ob >> 9) & 1) << 5)); }
__host__ __device__ __forceinline__ void stage_rc(int b, int& R, int& C) { const int st = b / 1024, sb = b % 1024, swz = sb ^ (((sb >> 9) & 1) << 5); R = (st >> 1) * 16 + swz / 64; C = (st & 1) * 32 + (swz % 64) / 2; }
__host__ __device__ __forceinline__ int perm32(int rho) { const int n = rho >> 4, i = rho & 15; return 8 * (i >> 2) + 4 * n + (i & 3); }

struct Unit { int pm, pn; };
struct Gemm { const bf16_t* A; const bf16_t* Bt; int M, N, K; };

struct StaticOrder {
    int nM, nN, nwg, G, c;
    __host__ __device__ void init(int M, int N, int G_, int c_) { nM = M / BM; nN = N / BM; nwg = nM * nN; G = G_; c = c_; }
    __host__ __device__ bool next(int i, Unit& u) const {
        const long L = (long)i * G + c; if (L >= nwg) return false;
        int wgid = (int)L; { const int q = nwg / NXCD, r = nwg % NXCD, xcd = wgid % NXCD, off = wgid / NXCD; wgid = (xcd < r ? xcd * (q + 1) : r * (q + 1) + (xcd - r) * q) + off; }
        const int nig = WGM * nN, gid = wgid / nig, fm = gid * WGM, gsz = (nM - fm) < WGM ? (nM - fm) : WGM;
        u.pm = fm + ((wgid % nig) % gsz); u.pn = (wgid % nig) / gsz; return true;
    }
    __device__ __forceinline__ void a_ready(const Unit&) const {}
    __device__ __forceinline__ void done(const Unit&) const {}
};
__device__ __forceinline__ unsigned cvt_pk_bf16(float lo, float hi) { unsigned r; asm volatile("v_cvt_pk_bf16_f32 %0, %1, %2" : "=v"(r) : "v"(lo), "v"(hi)); return r; }
template <int ACT> struct EpiBf16 {
    static constexpr bool PERM = true, AFTER_DRAIN = false;
    bf16_t* O; int ldc;
    __device__ __forceinline__ void operator()(const f32x4 (&acc)[2][2][4][2], const Unit& u, int wr, int wc, int fr, int fq) const {
        const int row0 = u.pm * BM + wr * 64 + fr, col0 = u.pn * BM + wc * 32 + 8 * fq;
#pragma unroll
        for (int ai = 0; ai < 2; ++ai)
#pragma unroll
            for (int m = 0; m < 4; ++m) { bf16_t* rowp = O + (size_t)(row0 + ai * HALF + m * 16) * ldc + col0;
#pragma unroll
                for (int bj = 0; bj < 2; ++bj) { f32x4 v0 = acc[ai][bj][m][0], v1 = acc[ai][bj][m][1];
                    if (ACT == 2) {
#pragma unroll
                        for (int e = 0; e < 4; ++e) { const float a = fmaxf(v0[e], 0.f), b = fmaxf(v1[e], 0.f); v0[e] = a * a; v1[e] = b * b; } }
                    u32x4 w; w.x = cvt_pk_bf16(v0[0], v0[1]); w.y = cvt_pk_bf16(v0[2], v0[3]); w.z = cvt_pk_bf16(v1[0], v1[1]); w.w = cvt_pk_bf16(v1[2], v1[3]);
                    *(u32x4*)(rowp + bj * HALF) = w; } }
    }
};
struct EpiResF32 {
    static constexpr bool PERM = false, AFTER_DRAIN = false;
    float* C; int ldc; const bf16_t* res; int ldr; float alpha;
    __device__ __forceinline__ void operator()(const f32x4 (&acc)[2][2][4][2], const Unit& u, int wr, int wc, int fr, int fq) const {
        typedef unsigned u32x2 __attribute__((ext_vector_type(2)));
        const int row0 = u.pm * BM + wr * 64 + fr, col0 = u.pn * BM + wc * 32 + 4 * fq;
#pragma unroll
        for (int ai = 0; ai < 2; ++ai)
#pragma unroll
            for (int m = 0; m < 4; ++m) { const int row = row0 + ai * HALF + m * 16; float* rowp = C + (size_t)row * ldc + col0; const bf16_t* rp = res + (size_t)row * ldr + col0;
#pragma unroll
                for (int bj = 0; bj < 2; ++bj)
#pragma unroll
                    for (int n = 0; n < 2; ++n) { const u32x2 rr = *(const u32x2*)(rp + bj * HALF + n * 16);
                        f32x4 o; o[0] = __uint_as_float(rr.x << 16); o[1] = __uint_as_float(rr.x & 0xffff0000u); o[2] = __uint_as_float(rr.y << 16); o[3] = __uint_as_float(rr.y & 0xffff0000u);
                        *(f32x4*)(rowp + bj * HALF + n * 16) = o * alpha + acc[ai][bj][m][n]; } }
    }
};

template <class Epi, class Sched, bool ALIGN_EPI = false, bool SP2 = false>
__device__ __forceinline__ void gemm_phase(PG8_LAS unsigned char* lds, const Gemm g, const Sched& S, const Epi& E) {
    const int tid = threadIdx.x, wid = __builtin_amdgcn_readfirstlane(tid >> 6), lane = tid & 63, wr = wid >> 2, wc = wid & 3, fr = lane & 15, fq = lane >> 4;
    const int K = g.K, nt = K / BK;
    unsigned voffA[2], voffB[2];
#pragma unroll
    for (int i = 0; i < 2; ++i) { int R, C; stage_rc(tid * 16 + i * 8192, R, C); const int Rb = Epi::PERM ? ((R & ~31) + perm32(R & 31)) : R;
        voffA[i] = (unsigned)(R * K + C) * 2u; voffB[i] = (unsigned)(Rb * K + C) * 2u; }
    const size_t kstep = (size_t)(BK * 2);
    const size_t hstep = (size_t)HALF * K * 2;
    const size_t tstep = 2 * hstep;
    const unsigned ldsw = (unsigned)wid * 1024u;
    const int aoff = lds_byte(wr * 64 + fr, fq * 8), boff = lds_byte(wc * 32 + fr, fq * 8);
#define PG8_SA(b, h) (((b) * 2 + (h)) * HTB)
#define PG8_SB(b, h) ((4 + (b) * 2 + (h)) * HTB)
#define PG8_STAGE(bufoff, gbase, voff) do { _Pragma("unroll") for (int _i = 0; _i < 2; ++_i) \
        __builtin_amdgcn_global_load_lds((const unsigned*)((const char*)(gbase) + (voff)[_i]), (PG8_LAS unsigned*)(lds + (bufoff) + ldsw + _i * 8192), 16, 0, 0); } while (0)
#define PG8_LDA(dst, b, h) do { _Pragma("unroll") for (int m = 0; m < 4; ++m) _Pragma("unroll") for (int k = 0; k < 2; ++k) dst[m][k] = *(const PG8_LAS bf16x8*)(lds + PG8_SA(b, h) + aoff + m * 2048 + k * 1024); } while (0)
#define PG8_LDB(dst, b, h) do { _Pragma("unroll") for (int n = 0; n < 2; ++n) _Pragma("unroll") for (int k = 0; k < 2; ++k) dst[n][k] = *(const PG8_LAS bf16x8*)(lds + PG8_SB(b, h) + boff + n * 2048 + k * 1024); } while (0)
#define PG8_MMA(ai, bj, At, Bt) do { __builtin_amdgcn_s_setprio(1); _Pragma("unroll") for (int m = 0; m < 4; ++m) _Pragma("unroll") for (int n = 0; n < 2; ++n) _Pragma("unroll") for (int k = 0; k < 2; ++k) \
        acc[ai][bj][m][n] = __builtin_amdgcn_mfma_f32_16x16x32_bf16(Bt[n][k], At[m][k], acc[ai][bj][m][n], 0, 0, 0); __builtin_amdgcn_s_setprio(0); } while (0)
#define PG8_WAIT_V(n) asm volatile("s_waitcnt vmcnt(" #n ")" ::: "memory")
#define PG8_WAIT_L(n) asm volatile("s_waitcnt lgkmcnt(" #n ")" ::: "memory")
#define PG8_BAR __builtin_amdgcn_s_barrier()
#define PG8_SCHED __builtin_amdgcn_sched_barrier(0)
    Unit cur, nxt; int ui = 0;
    if (!S.next(0, cur)) return;
    f32x4 acc[2][2][4][2];
#pragma unroll
    for (int a = 0; a < 2; ++a)
#pragma unroll
        for (int b = 0; b < 2; ++b)
#pragma unroll
            for (int m = 0; m < 4; ++m)
#pragma unroll
                for (int n = 0; n < 2; ++n) acc[a][b][m][n] = (f32x4){0.f, 0.f, 0.f, 0.f};
    bf16x8 At[4][2], B0[2][2], B1[2][2];
    const char* cA = (const char*)g.A + (size_t)cur.pm * tstep; const char* cB = (const char*)g.Bt + (size_t)cur.pn * tstep;
    S.a_ready(cur);
    if constexpr (SP2) {
        PG8_STAGE(PG8_SB(0, 0), cB, voffB); PG8_STAGE(PG8_SB(0, 1), cB + hstep, voffB); PG8_STAGE(PG8_SA(0, 0), cA, voffA); PG8_STAGE(PG8_SA(0, 1), cA + hstep, voffA);
        if (wr == 1) PG8_BAR;
        PG8_WAIT_V(2); PG8_BAR;
        PG8_STAGE(PG8_SB(1, 0), cB + kstep, voffB); PG8_STAGE(PG8_SA(1, 0), cA + kstep, voffA); PG8_STAGE(PG8_SB(1, 1), cB + hstep + kstep, voffB);
        PG8_WAIT_V(6); PG8_BAR;
    } else {
        PG8_STAGE(PG8_SB(0, 0), cB, voffB); PG8_STAGE(PG8_SA(0, 0), cA, voffA); PG8_STAGE(PG8_SB(0, 1), cB + hstep, voffB); PG8_STAGE(PG8_SA(0, 1), cA + hstep, voffA);
        if (wr == 1) PG8_BAR;
        PG8_WAIT_V(4); PG8_BAR;
        PG8_STAGE(PG8_SB(1, 0), cB + kstep, voffB); PG8_STAGE(PG8_SA(1, 0), cA + kstep, voffA); PG8_STAGE(PG8_SB(1, 1), cB + hstep + kstep, voffB);
        PG8_WAIT_V(6); PG8_BAR;
    }
    for (;;) {
        const bool has_next = S.next(ui + 1, nxt);
        const char* nA = has_next ? (const char*)g.A + (size_t)nxt.pm * tstep : cA; const char* nB = has_next ? (const char*)g.Bt + (size_t)nxt.pn * tstep : cB;
        for (int t = 0; t < nt; t += 2) {
            const bool last = (t == nt - 2);
            const char* a1 = cA + (size_t)(t + 1) * kstep;
            const char* a2 = last ? nA : cA + (size_t)(t + 2) * kstep; const char* b2 = last ? nB : cB + (size_t)(t + 2) * kstep;
            const char* a3 = a2 + kstep; const char* b3 = b2 + kstep;
            if (last && has_next) S.a_ready(nxt);
            if constexpr (SP2) {
            PG8_LDB(B0, 0, 0); PG8_LDB(B1, 0, 1); PG8_SCHED; PG8_LDA(At, 0, 0); PG8_STAGE(PG8_SA(1, 1), a1 + hstep, voffA);
            PG8_WAIT_V(8); PG8_WAIT_L(0); PG8_BAR; PG8_MMA(0, 0, At, B0); PG8_MMA(0, 1, At, B1); PG8_BAR; PG8_SCHED;
            PG8_LDA(At, 0, 1); PG8_STAGE(PG8_SB(0, 0), b2, voffB); PG8_STAGE(PG8_SB(0, 1), b2 + hstep, voffB); PG8_STAGE(PG8_SA(0, 0), a2, voffA);
            PG8_WAIT_V(8); PG8_WAIT_L(0); PG8_BAR; PG8_MMA(1, 0, At, B0); PG8_MMA(1, 1, At, B1); PG8_BAR; PG8_SCHED;
            PG8_LDB(B0, 1, 0); PG8_LDB(B1, 1, 1); PG8_SCHED; PG8_LDA(At, 1, 0); PG8_STAGE(PG8_SA(0, 1), a2 + hstep, voffA);
            PG8_WAIT_V(8); PG8_WAIT_L(0); PG8_BAR; PG8_MMA(0, 0, At, B0); PG8_MMA(0, 1, At, B1); PG8_BAR; PG8_SCHED;
            PG8_LDA(At, 1, 1); PG8_STAGE(PG8_SB(1, 0), b3, voffB); PG8_STAGE(PG8_SB(1, 1), b3 + hstep, voffB); PG8_STAGE(PG8_SA(1, 0), a3, voffA);
            PG8_WAIT_V(8); PG8_WAIT_L(0); PG8_BAR; PG8_MMA(1, 0, At, B0); PG8_MMA(1, 1, At, B1); PG8_BAR; PG8_SCHED;
            } else {
            PG8_LDB(B0, 0, 0); PG8_SCHED; PG8_LDA(At, 0, 0); PG8_STAGE(PG8_SA(1, 1), a1 + hstep, voffA);
            PG8_WAIT_L(8); PG8_BAR; PG8_WAIT_L(0); PG8_MMA(0, 0, At, B0); PG8_BAR; PG8_SCHED;
            PG8_LDB(B1, 0, 1); PG8_STAGE(PG8_SB(0, 0), b2, voffB);
            PG8_BAR; PG8_WAIT_L(0); PG8_MMA(0, 1, At, B1); PG8_BAR;
            PG8_LDA(At, 0, 1); PG8_STAGE(PG8_SA(0, 0), a2, voffA);
            PG8_BAR; PG8_WAIT_L(0); PG8_MMA(1, 0, At, B0); PG8_BAR; PG8_SCHED;
            PG8_STAGE(PG8_SB(0, 1), b2 + hstep, voffB);
            PG8_WAIT_V(6); PG8_BAR; PG8_MMA(1, 1, At, B1); PG8_BAR;
            PG8_LDB(B0, 1, 0); PG8_SCHED; PG8_LDA(At, 1, 0); PG8_STAGE(PG8_SA(0, 1), a2 + hstep, voffA);
            PG8_WAIT_L(8); PG8_BAR; PG8_WAIT_L(0); PG8_MMA(0, 0, At, B0); PG8_BAR; PG8_SCHED;
            PG8_LDB(B1, 1, 1); PG8_STAGE(PG8_SB(1, 0), b3, voffB);
            PG8_BAR; PG8_WAIT_L(0); PG8_MMA(0, 1, At, B1); PG8_BAR;
            PG8_LDA(At, 1, 1); PG8_STAGE(PG8_SA(1, 0), a3, voffA);
            PG8_BAR; PG8_WAIT_L(0); PG8_MMA(1, 0, At, B0); PG8_BAR; PG8_SCHED;
            PG8_STAGE(PG8_SB(1, 1), b3 + hstep, voffB);
            PG8_WAIT_V(6); PG8_BAR; PG8_MMA(1, 1, At, B1); PG8_BAR;
            }
        }
        if constexpr (ALIGN_EPI) { if (wr == 0) PG8_BAR; }
        if constexpr (!Epi::AFTER_DRAIN) { E(acc, cur, wr, wc, fr, fq); S.done(cur); }
        if (!has_next) break;
#pragma unroll
        for (int a = 0; a < 2; ++a)
#pragma unroll
            for (int b = 0; b < 2; ++b)
#pragma unroll
                for (int m = 0; m < 4; ++m)
#pragma unroll
                    for (int n = 0; n < 2; ++n) acc[a][b][m][n] = (f32x4){0.f, 0.f, 0.f, 0.f};
        cur = nxt; cA = nA; cB = nB; ++ui;
        if constexpr (ALIGN_EPI) { if (wr == 1) PG8_BAR; }
    }
    PG8_WAIT_V(0);
    if constexpr (!ALIGN_EPI) { if (wr == 0) PG8_BAR; }
    PG8_BAR;
    if constexpr (Epi::AFTER_DRAIN) { E.fused(acc, cur, wr, wc, fr, fq, lds, wid, lane); S.done(cur); }
#undef PG8_SA
#undef PG8_SB
#undef PG8_STAGE
#undef PG8_LDA
#undef PG8_LDB
#undef PG8_MMA
#undef PG8_WAIT_V
#undef PG8_WAIT_L
#undef PG8_BAR
#undef PG8_SCHED
}
}
#define GAS __attribute__((address_space(1)))
#define LAS __attribute__((address_space(3)))
#define XB_TMO      128
#define XB_XCNT(j)  (256  + 64 * (j))
#define XB_XSUB(j)  (1280 + 64 * (j))
#define XB_XGEN(j)  (2304 + 64 * (j))
#define XB_TOP      3328
#define XB_TOPGEN   3392
#define XCD_BAR_WORDS 3456
#define XB_SPIN_CAP (1u << 18)

__device__ __forceinline__ unsigned xb_ld(unsigned* p)              { return __hip_atomic_load(p, __ATOMIC_RELAXED, __HIP_MEMORY_SCOPE_AGENT); }
__device__ __forceinline__ unsigned xb_add(unsigned* p, unsigned v) { return __hip_atomic_fetch_add(p, v, __ATOMIC_RELAXED, __HIP_MEMORY_SCOPE_AGENT); }
__device__ __forceinline__ unsigned xb_xcc_id() { return (unsigned)__builtin_amdgcn_s_getreg((3 << 11) | 20) & 0xFu; }
#define XB_SPIN(cond, bar) do { unsigned _sp = 0; while (cond) { __builtin_amdgcn_s_sleep(1); \
    if ((++_sp & 255u) == 0u) { if (xb_ld(&(bar)[XB_TMO])) break; if (_sp > XB_SPIN_CAP) { atomicAdd(&(bar)[XB_TMO], 1u); break; } } } } while (0)

struct XcdBarrier {
    unsigned* bar; unsigned x;
    volatile LAS unsigned* st;
};

__device__ __forceinline__ XcdBarrier xcd_barrier_post(unsigned* bar, volatile LAS unsigned* st) {
    XcdBarrier b; b.bar = bar; b.x = xb_xcc_id(); b.st = st;
    if (threadIdx.x == 0) (void)xb_add(&bar[XB_XCNT(b.x)], 1u);
    return b;
}
__device__ __forceinline__ void xcd_barrier_complete(unsigned* bar, unsigned x, unsigned& nloc, unsigned& nx) {
    const unsigned G = gridDim.x * gridDim.y * gridDim.z;
    unsigned sum, cnt, mine, sp = 0u;
    for (;;) {
        sum = 0u; cnt = 0u; mine = 0u;
#pragma unroll
        for (unsigned j = 0; j < 16; ++j) { const unsigned c = xb_ld(&bar[XB_XCNT(j)]); sum += c; cnt += (c > 0u) ? 1u : 0u; mine = (j == x) ? c : mine; }
        if (sum == G) break;
        __builtin_amdgcn_s_sleep(1);
        if ((++sp & 255u) == 0u) { if (xb_ld(&bar[XB_TMO])) break; if (sp > XB_SPIN_CAP) { atomicAdd(&bar[XB_TMO], 1u); break; } }
    }
    nloc = mine > 0u ? mine : 1u; nx = cnt > 0u ? cnt : 1u;
}

__device__ __forceinline__ void xcd_barrier(const XcdBarrier& b) {
    asm volatile("s_waitcnt vmcnt(0)" ::: "memory");
    __syncthreads();
    if (threadIdx.x == 0) {
        unsigned* bar = b.bar;
        __builtin_amdgcn_s_waitcnt(0);
        unsigned nloc = b.st[0], nx = b.st[1];
        if (nloc == 0u) { xcd_barrier_complete(bar, b.x, nloc, nx); b.st[0] = nloc; b.st[1] = nx; }
        const unsigned old = xb_add(&bar[XB_XSUB(b.x)], 1u);
        const unsigned gen = old / nloc;
        if (old + 1u == (gen + 1u) * nloc) {
            __builtin_amdgcn_fence(__ATOMIC_RELEASE, "agent");
            asm volatile("s_waitcnt vmcnt(0)" ::: "memory");
            const unsigned og = xb_add(&bar[XB_TOP], 1u);
            const unsigned tg = og / nx;
            if (og + 1u == (tg + 1u) * nx) xb_add(&bar[XB_TOPGEN], 1u);
            else XB_SPIN(xb_ld(&bar[XB_TOPGEN]) == tg, bar);
            __builtin_amdgcn_fence(__ATOMIC_ACQUIRE, "agent");
            xb_add(&bar[XB_XGEN(b.x)], 1u);
            asm volatile("s_waitcnt vmcnt(0)" ::: "memory");
        } else {
            XB_SPIN(xb_ld(&bar[XB_XGEN(b.x)]) == gen, bar);
            __builtin_amdgcn_fence(__ATOMIC_ACQUIRE, "agent");
            asm volatile("s_waitcnt vmcnt(0)" ::: "memory");
        }
    }
    __syncthreads();
}

#define GAS __attribute__((address_space(1)))
#define LAS __attribute__((address_space(3)))
typedef unsigned short bf16;
typedef unsigned v4u __attribute__((ext_vector_type(4)));
typedef unsigned v2u __attribute__((ext_vector_type(2)));
typedef float f32x4 __attribute__((ext_vector_type(4)));
typedef short bf16x8 __attribute__((ext_vector_type(8)));

constexpr int NWAVES = 8, NTHR = 512;
#ifndef MK_N_LAUNCHES
#define MK_N_LAUNCHES 1
#endif
constexpr int NPH = 10;
constexpr int N_LAUNCHES = MK_N_LAUNCHES;

constexpr int DM = 1024, NPR = 16400  , NTOK = 17424, MP = 17664  , M2 = 17408  , ROW0 = 16;
constexpr int NPROJ = 2816  , WIN_LD = 2832, DFF = 4096;
constexpr int NCHP = 257, NCH = 289, NITEM = NCH * 8;
constexpr int C_K = 512, C_V = 1024, C_Z = 1536, C_SQ = 2048, C_SK = 2560, C_SV = 2688;
constexpr float LN_EPS = 1e-5f, NORM_EPS = 1e-6f, DEEP_ALPHA = 1.189207115002721f;
constexpr size_t O_Y = 0, O_PSD = 17825792, O_PSC = 17858560, O_PK = 17863168, O_PV = 17879552, O_SSD = 17895936, O_SSC = 18944512, O_SK = 19091968, O_SV = 19223040, O_END = 19354112;
constexpr size_t OB_MIX = 0, OB_SC = 35684352, OB_GB = 54624256;
constexpr size_t MiB = 1u << 20;
constexpr size_t WS_CTL = 0, CTL_ZERO_BYTES = 64 * 1024, WS_GT = 1 * MiB, WS_WIN = 4 * MiB, WS_WO = 10 * MiB, WS_W1 = 12 * MiB, WS_W2 = 20 * MiB, WS_H = 28 * MiB, WS_BIG = 63 * MiB;
constexpr size_t WS_PROJ = WS_BIG, WS_PREP = 158 * MiB, PREP_ARR = (size_t)NITEM * 8192;
constexpr size_t WS_Z1 = WS_BIG, WS_HID = WS_BIG, WS_END = 232 * MiB;
static_assert(WS_H + (size_t)MP * DM * 2 <= WS_BIG && WS_PROJ + (size_t)MP * NPROJ * 2 <= WS_PREP && WS_PREP + 4 * PREP_ARR <= WS_END && WS_HID + (size_t)M2 * DFF * 2 <= WS_END, "ws map");
static_assert(OB_GB + (size_t)NTOK * 64 <= (size_t)M2 * DM * 4 && OB_SC + (size_t)NITEM * 8192 <= OB_GB && (size_t)NTOK * DM * 2 <= OB_SC, "d_out scratch map");
constexpr int CW_BAR = 4096;
constexpr int RING_BYTES = 131072, LDSCTL_OFF = RING_BYTES, MISC_OFF = LDSCTL_OFF + 320, LDS_BYTES = 147456;

__device__ __forceinline__ float bf2f(unsigned h) { return __uint_as_float(h << 16); }
typedef float f32x2_t __attribute__((ext_vector_type(2))); typedef __bf16 bf16x2_t __attribute__((ext_vector_type(2)));
__device__ __forceinline__ unsigned pk2(float lo, float hi) { const f32x2_t v = {lo, hi}; const bf16x2_t b = __builtin_convertvector(v, bf16x2_t); return __builtin_bit_cast(unsigned, b); }
__device__ __forceinline__ bf16 f2bf(float f) { return (bf16)(pk2(f, 0.f) & 0xffffu); }
__device__ __forceinline__ void unpack8(const v4u r, float (&x)[8]) {
    x[0] = __uint_as_float(r.x << 16); x[1] = __uint_as_float(r.x & 0xffff0000u); x[2] = __uint_as_float(r.y << 16); x[3] = __uint_as_float(r.y & 0xffff0000u);
    x[4] = __uint_as_float(r.z << 16); x[5] = __uint_as_float(r.z & 0xffff0000u); x[6] = __uint_as_float(r.w << 16); x[7] = __uint_as_float(r.w & 0xffff0000u);
}
__device__ __forceinline__ bf16x8 pack8(const f32x4 a, const f32x4 b) {
    v4u w; w.x = pk2(a[0], a[1]); w.y = pk2(a[2], a[3]); w.z = pk2(b[0], b[1]); w.w = pk2(b[2], b[3]); return __builtin_bit_cast(bf16x8, w);
}
__device__ __forceinline__ f32x4 mfma16(bf16x8 a, bf16x8 b, f32x4 c) { return __builtin_amdgcn_mfma_f32_16x16x32_bf16(a, b, c, 0, 0, 0); }
__device__ __forceinline__ float wave_sum(float v) {
#pragma unroll
    for (int o = 1; o < 64; o <<= 1) v += __shfl_xor(v, o);
    return v;
}

struct Args { const float* in[23]; float* out; unsigned char* ws; int ph_lo, ph_hi, li, pad; };

struct Frame { LAS unsigned char* lds; int tid, lane, wave, fr, fq, G, bid; };
#define WSB(T, off) ((T*)(A.ws + (off)))
#define OBB(T, off) ((T*)((unsigned char*)A.out + (off)))


__device__ __forceinline__ int slot_row(int chunk, int i) {
    if (chunk < NCHP) return 64 * chunk + i - 48;
    return i >= 32 ? NPR + 32 * (chunk - NCHP) + (i - 32) : -1;
}

__device__ __forceinline__ void p0_transpose_item(const float* W, int ldw, int srccol0, bf16* WT, int K, int dstrow0, LAS float* scr, int k0, int lane) {
#pragma unroll 8
    for (int i = 0; i < 32; ++i) { const int kk = 2 * i + (lane >> 5); scr[kk * 33 + (lane & 31)] = W[(size_t)(k0 + kk) * ldw + srccol0 + (lane & 31)]; }
    asm volatile("s_waitcnt lgkmcnt(0)" ::: "memory");
    const int c = lane & 7;
#pragma unroll
    for (int j = 0; j < 4; ++j) { const int n = (lane >> 3) + 8 * j; const LAS float* s = scr + (8 * c) * 33 + n;
        v4u o; o.x = pk2(s[0 * 33], s[1 * 33]); o.y = pk2(s[2 * 33], s[3 * 33]); o.z = pk2(s[4 * 33], s[5 * 33]); o.w = pk2(s[6 * 33], s[7 * 33]);
        *(GAS v4u*)(WT + (size_t)(dstrow0 + n) * K + k0 + 8 * c) = o; }
    asm volatile("s_waitcnt lgkmcnt(0)" ::: "memory");
}

__device__ __forceinline__ void p0_prologue(const Frame& F, const Args& A) {
    const int gw = F.bid * NWAVES + F.wave, NGW = F.G * NWAVES, lane = F.lane;
    {
        LAS float* scr = (LAS float*)(F.lds + F.wave * 16384);
        constexpr int I_IN = 16 * 88, I_O = 16 * 32, I_1 = 16 * 128, I_2 = 64 * 32, NITEMS = I_IN + I_O + I_1 + I_2;
        for (int it = gw; it < NITEMS; it += NGW) {
            int r = it;
            if (r < I_IN) { const int kb = r / 88, nb = r % 88, n0 = 32 * nb; p0_transpose_item(A.in[9], WIN_LD, n0 < 2048 ? n0 : n0 + 16, WSB(bf16, WS_WIN), DM, n0, scr, 64 * kb, lane); continue; } r -= I_IN;
            if (r < I_O) { const int kb = r / 32, nb = r % 32; p0_transpose_item(A.in[16], DM, 32 * nb, WSB(bf16, WS_WO), DM, 32 * nb, scr, 64 * kb, lane); continue; } r -= I_O;
            if (r < I_1) { const int kb = r / 128, nb = r % 128; p0_transpose_item(A.in[19], DFF, 32 * nb, WSB(bf16, WS_W1), DM, 32 * nb, scr, 64 * kb, lane); continue; } r -= I_1;
            { const int kb = r / 32, nb = r % 32; p0_transpose_item(A.in[20], DM, 32 * nb, WSB(bf16, WS_W2), DFF, 32 * nb, scr, 64 * kb, lane); }
        }
    }
    __syncthreads();
    LAS float* wab = (LAS float*)F.lds;
    for (int idx = F.tid; idx < 16384; idx += NTHR) { const int k = idx >> 4, e = idx & 15; wab[e * 1024 + k] = A.in[9][(size_t)k * WIN_LD + 2048 + e]; }
    __syncthreads();
    f32x4 lg[4], lb[4];
#pragma unroll
    for (int j = 0; j < 4; ++j) { lg[j] = ((const GAS f32x4*)A.in[7])[64 * j + lane]; lb[j] = ((const GAS f32x4*)A.in[8])[64 * j + lane]; }
    const float hp_a = (lane < 8) ? -__expf(A.in[11][lane & 7]) : 0.f, hp_b = A.in[12][lane & 7];
    for (int m = gw; m < MP; m += NGW) {
        GAS unsigned long long* o8 = (GAS unsigned long long*)(WSB(bf16, WS_H) + (size_t)m * DM) + lane;
        if (m >= NTOK) {
#pragma unroll
            for (int j = 0; j < 4; ++j) o8[64 * j] = 0ull;
            continue; }
        const float* xrow = m < ROW0 ? A.in[6] + (size_t)m * DM : (m < NPR ? A.in[0] + (size_t)(m - ROW0) * DM : A.in[1] + (size_t)(m - NPR) * DM);
        const GAS f32x4* xr = (const GAS f32x4*)xrow + lane;
        f32x4 v[4]; float s = 0.f;
#pragma unroll
        for (int j = 0; j < 4; ++j) { v[j] = xr[64 * j]; s += (v[j].x + v[j].y) + (v[j].z + v[j].w); }
        const float mean = wave_sum(s) * (1.f / DM); float s2 = 0.f;
#pragma unroll
        for (int j = 0; j < 4; ++j) { v[j] = v[j] - mean; s2 += (v[j].x * v[j].x + v[j].y * v[j].y) + (v[j].z * v[j].z + v[j].w * v[j].w); }
        const float rstd = 1.f / sqrtf(wave_sum(s2) * (1.f / DM) + LN_EPS);
#pragma unroll
        for (int j = 0; j < 4; ++j) { v[j] = v[j] * rstd * lg[j] + lb[j];
            o8[64 * j] = (unsigned long long)pk2(v[j].x, v[j].y) | ((unsigned long long)pk2(v[j].z, v[j].w) << 32); }
        float ab = 0.f;
#pragma unroll
        for (int e = 0; e < 16; ++e) { float p = 0.f;
#pragma unroll
            for (int j = 0; j < 4; ++j) { const f32x4 w = *(const LAS f32x4*)(wab + e * 1024 + 256 * j + 4 * lane); p += (v[j].x * w.x + v[j].y * w.y) + (v[j].z * w.z + v[j].w * w.w); }
            p = wave_sum(p); if (lane == e) ab = p; }
        if (lane < 16) {
            float r;
            if (lane < 8) { const float xx = ab + hp_b; const float sp = fmaxf(xx, 0.f) + log1pf(__expf(-fabsf(xx))); r = hp_a * sp; }
            else r = 1.f / (1.f + __expf(-ab));
            OBB(float, OB_GB)[(size_t)m * 16 + lane] = r; }
    }
}

constexpr int L_QH = 0, L_KH = 9216, L_VH = 18432, L_KDT = 27648, L_QKB = 36864, L_WUT = 46080, L_AF = 64512, L_GS = 80896, L_BS = 81152, L_R = 81408;
constexpr int L_KS = 0, L_VT = 27648, L_BREL = 118784;

__device__ __forceinline__ void load8(float (&x)[8], const Args& A, int chunk, int slot, int colb) {
    if (chunk < NCHP) {
        const int row = 64 * chunk + slot - 48;
        if (row >= 0) { unpack8(*(const GAS v4u*)(WSB(bf16, WS_PROJ) + (size_t)row * NPROJ + colb), x); return; }
    } else {
        const int b = chunk - NCHP, ti = slot - 32;
        if (ti >= 0) { unpack8(*(const GAS v4u*)(WSB(bf16, WS_PROJ) + (size_t)(NPR + 32 * b + ti) * NPROJ + colb), x); return; }
        if (ti >= -3) { const GAS f32x4* p = (const GAS f32x4*)(A.in[3] + ((size_t)b * 3 + (3 + ti)) * 1536 + colb); const f32x4 a = p[0], c = p[1];
            x[0] = a.x; x[1] = a.y; x[2] = a.z; x[3] = a.w; x[4] = c.x; x[5] = c.y; x[6] = c.z; x[7] = c.w; return; }
    }
#pragma unroll
    for (int e = 0; e < 8; ++e) x[e] = 0.f;
}

__device__ __forceinline__ void prep_item(const Frame& F, const Args& A, int chunk, int h) {
    LAS bf16* qh = (LAS bf16*)(F.lds + L_QH); LAS bf16* kh = (LAS bf16*)(F.lds + L_KH); LAS bf16* vh = (LAS bf16*)(F.lds + L_VH);
    LAS bf16* kdT = (LAS bf16*)(F.lds + L_KDT); LAS bf16* qkb = (LAS bf16*)(F.lds + L_QKB); LAS bf16* WUT = (LAS bf16*)(F.lds + L_WUT);
    LAS float* Af = (LAS float*)(F.lds + L_AF); LAS float* Gs = (LAS float*)(F.lds + L_GS); LAS float* Bs = (LAS float*)(F.lds + L_BS);
    const int t = F.tid, lane = F.lane, fr = F.fr, fq = F.fq, item = chunk * 8 + h;
    if (t < 384) {
        const int which = t >> 7, rem = t & 127, tr = rem >> 3, dg = rem & 7, i0 = tr * 4, colb = which * 512 + h * 64 + dg * 8;
        float x[7][8], w[4][8];
#pragma unroll
        for (int n = 0; n < 7; ++n) load8(x[n], A, chunk, i0 - 3 + n, colb);
#pragma unroll
        for (int j = 0; j < 4; ++j) { const GAS f32x4* p = (const GAS f32x4*)(A.in[10] + (size_t)j * 1536 + colb); const f32x4 a = p[0], c = p[1];
            w[j][0] = a.x; w[j][1] = a.y; w[j][2] = a.z; w[j][3] = a.w; w[j][4] = c.x; w[j][5] = c.y; w[j][6] = c.z; w[j][7] = c.w; }
        LAS bf16* dst = which == 0 ? qh : (which == 1 ? kh : vh);
#pragma unroll
        for (int no = 0; no < 4; ++no) {
            const int slot = i0 + no; const bool valid = slot_row(chunk, slot) >= 0;
            float y[8]; float ss = 0.f;
#pragma unroll
            for (int e = 0; e < 8; ++e) { float a = x[no][e] * w[0][e] + x[no + 1][e] * w[1][e] + x[no + 2][e] * w[2][e] + x[no + 3][e] * w[3][e];
                a = a / (1.f + __expf(-a)); a = valid ? a : 0.f; y[e] = a; ss += a * a; }
            ss += __shfl_xor(ss, 1); ss += __shfl_xor(ss, 2); ss += __shfl_xor(ss, 4);
            const float sc = which == 2 ? 1.f : (rsqrtf(ss + NORM_EPS) * (which == 0 ? 0.125f : 1.f));
            v4u o; o.x = pk2(y[0] * sc, y[1] * sc); o.y = pk2(y[2] * sc, y[3] * sc); o.z = pk2(y[4] * sc, y[5] * sc); o.w = pk2(y[6] * sc, y[7] * sc);
            *(LAS v4u*)(dst + slot * 72 + dg * 8) = o;
        }
    } else if (t < 448) {
        const int i = t - 384, row = slot_row(chunk, i);
        Gs[i] = row >= 0 ? OBB(float, OB_GB)[(size_t)row * 16 + h] : 0.f; Bs[i] = row >= 0 ? OBB(float, OB_GB)[(size_t)row * 16 + 8 + h] : 0.f;
    }
    __syncthreads();
    if (F.wave == 0) { float x = Gs[lane];
#pragma unroll
        for (int d = 1; d < 64; d <<= 1) { const float y = __shfl_up(x, d); if (lane >= d) x += y; }
        Gs[lane] = x; }
    __syncthreads();
    {
        const int p = F.wave >> 2, mt = F.wave & 3; LAS const bf16* src = p ? qh : kh;
        const bf16x8 a0 = *(LAS const bf16x8*)(src + (16 * mt + fr) * 72 + 8 * fq), a1 = *(LAS const bf16x8*)(src + (16 * mt + fr) * 72 + 32 + 8 * fq);
#pragma unroll
        for (int nt = 0; nt < 4; ++nt) {
            const int j = 16 * nt + fr;
            if (nt <= mt) {
                const bf16x8 b0 = *(LAS const bf16x8*)(kh + j * 72 + 8 * fq), b1 = *(LAS const bf16x8*)(kh + j * 72 + 32 + 8 * fq);
                f32x4 acc = {0.f, 0.f, 0.f, 0.f}; acc = mfma16(a0, b0, acc); acc = mfma16(a1, b1, acc);
                const float gj = Gs[j];
#pragma unroll
                for (int r = 0; r < 4; ++r) { const int i = 16 * mt + 4 * fq + r; const float dec = __expf(fminf(Gs[i] - gj, 0.f));
                    if (p == 0) Af[i * 64 + j] = (i > j) ? Bs[i] * acc[r] * dec : 0.f;
                    else qkb[i * 72 + j] = f2bf((i >= j) ? acc[r] * dec : 0.f); }
            } else if (p == 1) {
#pragma unroll
                for (int r = 0; r < 4; ++r) qkb[(16 * mt + 4 * fq + r) * 72 + j] = 0;
            }
        }
        const int c = t & 63, dg = t >> 6; const float f = __expf(Gs[63] - Gs[c]); float kv[8];
        unpack8(*(LAS const v4u*)(kh + c * 72 + 8 * dg), kv);
#pragma unroll
        for (int e = 0; e < 8; ++e) kdT[(8 * dg + e) * 72 + c] = f2bf(kv[e] * f);
        LAS float* Rs = (LAS float*)(F.lds + L_R);
#pragma unroll
        for (int rep = 0; rep < 2; ++rep) { const int i = (t >> 4) + 32 * rep, c8 = t & 15; const bool isw = c8 < 8; float rv[8];
            unpack8(*(LAS const v4u*)((isw ? kh : vh) + i * 72 + 8 * (c8 & 7)), rv); const float f2 = Bs[i] * (isw ? __expf(Gs[i]) : 1.f);
            const f32x4 r0 = {rv[0] * f2, rv[1] * f2, rv[2] * f2, rv[3] * f2}, r1 = {rv[4] * f2, rv[5] * f2, rv[6] * f2, rv[7] * f2};
            *(LAS f32x4*)(Rs + i * 128 + 8 * c8) = r0; *(LAS f32x4*)(Rs + i * 128 + 8 * c8 + 4) = r1; }
    }
    __syncthreads();
#ifndef NO_SOLVE
    if (F.wave < 2) {
        float x[64];
#pragma unroll
        for (int i = 0; i < 64; ++i) x[i] = 0.f;
        LAS const float* Ao = Af; LAS const float* Ro = (LAS const float*)(F.lds + L_R) + t;
        asm volatile("" : "+v"(Ao), "+v"(Ro));
#pragma unroll
        for (int i = 0; i < 64; ++i) {
            float s = Ro[i * 128];
#pragma unroll
            for (int j4 = 0; j4 < (i + 3) / 4; ++j4) { const f32x4 a = *(LAS const f32x4*)(Ao + i * 64 + 4 * j4);
                s -= a.x * x[4 * j4]; s -= a.y * x[4 * j4 + 1]; s -= a.z * x[4 * j4 + 2]; s -= a.w * x[4 * j4 + 3]; }
            x[i] = s;
        }
#pragma unroll
        for (int c8 = 0; c8 < 8; ++c8) { v4u o; o.x = pk2(x[8 * c8], x[8 * c8 + 1]); o.y = pk2(x[8 * c8 + 2], x[8 * c8 + 3]); o.z = pk2(x[8 * c8 + 4], x[8 * c8 + 5]); o.w = pk2(x[8 * c8 + 6], x[8 * c8 + 7]);
            *(LAS v4u*)(WUT + t * 72 + 8 * c8) = o; }
    }
#endif
    __syncthreads();
    {
        const int w4 = F.wave & 3; const bool second = F.wave >= 4;
        {
            LAS const bf16* bsrc = second ? qkb : kdT;
            const bf16x8 b0 = *(LAS const bf16x8*)(bsrc + (16 * w4 + fr) * 72 + 8 * fq), b1 = *(LAS const bf16x8*)(bsrc + (16 * w4 + fr) * 72 + 32 + 8 * fq);
            f32x4 cp[4];
#pragma unroll
            for (int mt = 0; mt < 4; ++mt) { const bf16x8 a0 = *(LAS const bf16x8*)(WUT + (16 * mt + fr) * 72 + 8 * fq), a1 = *(LAS const bf16x8*)(WUT + (16 * mt + fr) * 72 + 32 + 8 * fq);
                f32x4 acc = {0.f, 0.f, 0.f, 0.f}; acc = mfma16(a0, b0, acc); acc = mfma16(a1, b1, acc); cp[mt] = acc; }
            if (!second) {
#pragma unroll
                for (int mt = 0; mt < 4; ++mt) cp[mt] = -cp[mt];
            } else {
                const int i = 16 * w4 + fr; const float eg = __expf(Gs[i]);
#pragma unroll
                for (int mt = 0; mt < 4; ++mt) { const v2u qq = *(LAS const v2u*)(qh + i * 72 + 16 * mt + 4 * fq);
                    cp[mt][0] = bf2f(qq.x & 0xffffu) * eg - cp[mt][0]; cp[mt][1] = bf2f(qq.x >> 16) * eg - cp[mt][1]; cp[mt][2] = bf2f(qq.y & 0xffffu) * eg - cp[mt][2]; cp[mt][3] = bf2f(qq.y >> 16) * eg - cp[mt][3]; }
            }
            bf16* dstg = (second ? WSB(bf16, WS_PREP + PREP_ARR) : WSB(bf16, WS_PREP)) + (size_t)item * 4096;
            *(GAS bf16x8*)(dstg + ((w4 * 2 + 0) * 64 + lane) * 8) = pack8(cp[0], cp[1]);
            *(GAS bf16x8*)(dstg + ((w4 * 2 + 1) * 64 + lane) * 8) = pack8(cp[2], cp[3]);
        }
        {
            LAS const bf16* asrc = second ? qkb : kdT;
            const bf16x8 a0 = *(LAS const bf16x8*)(asrc + (16 * w4 + fr) * 72 + 8 * fq), a1 = *(LAS const bf16x8*)(asrc + (16 * w4 + fr) * 72 + 32 + 8 * fq);
            bf16* dstg = (second ? WSB(bf16, WS_PREP + 3 * PREP_ARR) : WSB(bf16, WS_PREP + 2 * PREP_ARR)) + (size_t)item * 4096;
#pragma unroll
            for (int nt = 0; nt < 4; ++nt) { const bf16x8 b0 = *(LAS const bf16x8*)(WUT + (64 + 16 * nt + fr) * 72 + 8 * fq), b1 = *(LAS const bf16x8*)(WUT + (64 + 16 * nt + fr) * 72 + 32 + 8 * fq);
                f32x4 acc = {0.f, 0.f, 0.f, 0.f}; acc = mfma16(a0, b0, acc); acc = mfma16(a1, b1, acc);
                v2u o; o.x = pk2(acc[0], acc[1]); o.y = pk2(acc[2], acc[3]);
                *(GAS v2u*)(dstg + ((nt * 4 + w4) * 64 + lane) * 4) = o; }
        }
        if (t == 0) WSB(float, WS_GT)[item] = __expf(Gs[63]);
    }
    __syncthreads();
}

__device__ __forceinline__ void swa_item(const Frame& F, const Args& A, int chunk, int kvh) {
    LAS bf16* Ks = (LAS bf16*)(F.lds + L_KS); LAS bf16* VT = (LAS bf16*)(F.lds + L_VT); LAS const float* brel = (LAS const float*)(F.lds + L_BREL);
    const int t = F.tid, lane = F.lane, fr = F.fr, fq = F.fq;
#pragma nounroll
    for (int idx = t; idx < 1536; idx += NTHR) {
        const int key = idx >> 3, dg = idx & 7; float kx[8], vx[8]; bool have = false;
        if (chunk < NCHP) { const int row = 64 * chunk + key - 128 - 48;
            if (row >= 0) { unpack8(*(const GAS v4u*)(WSB(bf16, WS_PROJ) + (size_t)row * NPROJ + C_SK + kvh * 64 + 8 * dg), kx); unpack8(*(const GAS v4u*)(WSB(bf16, WS_PROJ) + (size_t)row * NPROJ + C_SV + kvh * 64 + 8 * dg), vx); have = true; }
        } else { const int b = chunk - NCHP;
            if (key >= 160) { const int row = NPR + 32 * b + (key - 160);
                unpack8(*(const GAS v4u*)(WSB(bf16, WS_PROJ) + (size_t)row * NPROJ + C_SK + kvh * 64 + 8 * dg), kx); unpack8(*(const GAS v4u*)(WSB(bf16, WS_PROJ) + (size_t)row * NPROJ + C_SV + kvh * 64 + 8 * dg), vx); have = true; }
            else if (key >= 32) { const size_t off = (((size_t)b * 128 + (key - 32)) * 2 + kvh) * 64 + 8 * dg;
                const GAS f32x4* pk = (const GAS f32x4*)(A.in[4] + off); const GAS f32x4* pv = (const GAS f32x4*)(A.in[5] + off); const f32x4 a = pk[0], c = pk[1], d = pv[0], e = pv[1];
                kx[0] = a.x; kx[1] = a.y; kx[2] = a.z; kx[3] = a.w; kx[4] = c.x; kx[5] = c.y; kx[6] = c.z; kx[7] = c.w;
                vx[0] = d.x; vx[1] = d.y; vx[2] = d.z; vx[3] = d.w; vx[4] = e.x; vx[5] = e.y; vx[6] = e.z; vx[7] = e.w; have = true; }
        }
        if (!have) {
#pragma unroll
            for (int e = 0; e < 8; ++e) { kx[e] = 0.f; vx[e] = 0.f; } }
        v4u o; o.x = pk2(kx[0], kx[1]); o.y = pk2(kx[2], kx[3]); o.z = pk2(kx[4], kx[5]); o.w = pk2(kx[6], kx[7]);
        *(LAS v4u*)(Ks + key * 72 + 8 * dg) = o;
#pragma unroll
        for (int e = 0; e < 8; ++e) VT[(8 * dg + e) * 200 + key] = f2bf(vx[e]);
    }
    __syncthreads();
    const int hq = kvh * 4 + (F.wave >> 1), qt0 = (F.wave & 1) * 2;
    const int kv0 = chunk < NCHP ? (176 - 64 * chunk > 0 ? 176 - 64 * chunk : 0) : 32;
    const float sink = A.in[14][hq];
#pragma nounroll
    for (int qi = 0; qi < 2; ++qi) {
        f32x4 sc[12];
        LAS const bf16* kp = Ks + fr * 72 + 8 * fq; LAS const bf16* vp = VT + fr * 200 + 4 * fq;
        const int qs = 16 * (qt0 + qi) + fr;
        LAS const float* bp = brel + hq * 256 + 63 + 4 * fq - qs;
        asm volatile("" : "+v"(kp), "+v"(vp), "+v"(bp));
        {
            const int row = slot_row(chunk, qs);
            bf16x8 bq0 = {0, 0, 0, 0, 0, 0, 0, 0}, bq1 = {0, 0, 0, 0, 0, 0, 0, 0};
            if (row >= 0) { const GAS bf16x8* qp = (const GAS bf16x8*)(WSB(bf16, WS_PROJ) + (size_t)row * NPROJ + C_SQ + hq * 64 + 8 * fq); bq0 = qp[0]; bq1 = qp[4]; }
#pragma unroll
            for (int kt = 0; kt < 12; ++kt) { const bf16x8 a0 = *(LAS const bf16x8*)(kp + kt * 16 * 72), a1 = *(LAS const bf16x8*)(kp + kt * 16 * 72 + 32);
                f32x4 acc = {0.f, 0.f, 0.f, 0.f}; acc = mfma16(a0, bq0, acc); acc = mfma16(a1, bq1, acc); sc[kt] = acc; }
            float mx = sink;
#pragma unroll
            for (int kt = 0; kt < 12; ++kt)
#pragma unroll
                for (int r = 0; r < 4; ++r) { const int key = 16 * kt + 4 * fq + r; float s = sc[kt][r] * 0.125f + bp[16 * kt + r];
                    s = key < kv0 ? -INFINITY : s; sc[kt][r] = s; mx = fmaxf(mx, s); }
            mx = fmaxf(mx, __shfl_xor(mx, 16)); mx = fmaxf(mx, __shfl_xor(mx, 32));
            float sum = 0.f;
#pragma unroll
            for (int kt = 0; kt < 12; ++kt)
#pragma unroll
                for (int r = 0; r < 4; ++r) { const float p = __expf(sc[kt][r] - mx); sc[kt][r] = p; sum += p; }
            sum += __shfl_xor(sum, 16); sum += __shfl_xor(sum, 32);
            const float inv = 1.f / (sum + __expf(sink - mx));
#pragma unroll
            for (int kt = 0; kt < 12; ++kt) sc[kt] = sc[kt] * inv;
        }
        f32x4 o[4];
#pragma unroll
        for (int dt = 0; dt < 4; ++dt) o[dt] = (f32x4){0.f, 0.f, 0.f, 0.f};
#pragma unroll
        for (int ks = 0; ks < 6; ++ks) {
            const bf16x8 pa = pack8(sc[2 * ks], sc[2 * ks + 1]);
#pragma unroll
            for (int dt = 0; dt < 4; ++dt) { const v2u lo = *(LAS const v2u*)(vp + dt * 16 * 200 + 32 * ks), hi = *(LAS const v2u*)(vp + dt * 16 * 200 + 32 * ks + 16);
                v4u w; w.x = lo.x; w.y = lo.y; w.z = hi.x; w.w = hi.y; o[dt] = mfma16(pa, __builtin_bit_cast(bf16x8, w), o[dt]); }
        }
#pragma unroll
        for (int r = 0; r < 4; ++r) { const int row = slot_row(chunk, 16 * (qt0 + qi) + 4 * fq + r);
            if (row >= 0) {
#pragma unroll
                for (int dt = 0; dt < 4; ++dt) OBB(bf16, OB_MIX)[(size_t)row * DM + 512 + hq * 64 + 16 * dt + fr] = f2bf(o[dt][r]); } }
    }
    __syncthreads();
}

__device__ __forceinline__ void p2_phase(const Frame& F, const Args& A) {
    LAS float* brel = (LAS float*)(F.lds + L_BREL);
    for (int idx = F.tid; idx < 8 * 256; idx += NTHR) { const int hq = idx >> 8, rel = (idx & 255) - 191, n = rel < 0 ? -rel : rel;
        int bkt; if (n < 8) bkt = n; else { const int large = 8 + (31 - __clz(n * n)) - 6; bkt = large < 15 ? large : 15; }
        if (rel > 0) bkt += 16;
        brel[idx] = (idx & 255) < 255 ? A.in[15][bkt * 8 + hq] : 0.f; }
    {
        const size_t gt = (size_t)F.bid * NTHR + F.tid, GS = (size_t)F.G * NTHR;
        constexpr size_t n0 = 4608, n1 = n0 + 16384, n2 = n1 + 16384, n3 = n2 + 147456, n4 = n3 + 131072, n5 = n4 + 131072;
        for (size_t i = gt; i < n5; i += GS) {
            size_t oo; size_t row; int col;
            if (i < n0) { row = NPR - 3 + i / 1536; col = (int)(i % 1536); oo = O_PSC + i; }
            else if (i < n1) { const size_t k = i - n0; row = NPR - 128 + k / 128; col = C_SK + (int)(k % 128); oo = O_PK + k; }
            else if (i < n2) { const size_t k = i - n1; row = NPR - 128 + k / 128; col = C_SV + (int)(k % 128); oo = O_PV + k; }
            else if (i < n3) { const size_t k = i - n2; const size_t b = k / 4608, rr = (k % 4608) / 1536; row = NPR + 32 * b + 29 + rr; col = (int)(k % 1536); oo = O_SSC + k; }
            else if (i < n4) { const size_t k = i - n3; row = NPR + k / 128; col = C_SK + (int)(k % 128); oo = O_SK + k; }
            else { const size_t k = i - n4; row = NPR + k / 128; col = C_SV + (int)(k % 128); oo = O_SV + k; }
            A.out[oo] = bf2f(WSB(bf16, WS_PROJ)[row * NPROJ + col]);
        }
    }
    __syncthreads();
    for (int it = F.bid; it < NITEM + NCH * 2; it += F.G) {
#ifndef NO_PREP
        if (it < NITEM) prep_item(F, A, it >> 3, it & 7);
#endif
#ifndef NO_SWA
        if (it >= NITEM) { const int k = it - NITEM; swa_item(F, A, k >> 1, k & 1); }
#endif
    }
}

__device__ __forceinline__ void scan_job(const Frame& F, const Args& A, int h, int chunk0, int nsteps, const float* S0, float* Sout) {
    const int nt = F.wave, lane = F.lane, fr = F.fr, fq = F.fq;
    f32x4 S[4];
#pragma unroll
    for (int mt = 0; mt < 4; ++mt)
#pragma unroll
        for (int r = 0; r < 4; ++r) S[mt][r] = S0 ? S0[(16 * mt + 4 * fq + r) * 64 + 16 * nt + fr] : 0.f;
    size_t item = (size_t)chunk0 * 8 + h;
    bf16x8 q[4][2]; v2u nb[4]; float gt;
#pragma unroll
    for (int mt = 0; mt < 4; ++mt) { q[mt][0] = *(const GAS bf16x8*)(WSB(bf16, WS_PREP) + item * 4096 + ((mt * 2 + 0) * 64 + lane) * 8); q[mt][1] = *(const GAS bf16x8*)(WSB(bf16, WS_PREP) + item * 4096 + ((mt * 2 + 1) * 64 + lane) * 8);
        nb[mt] = *(const GAS v2u*)(WSB(bf16, WS_PREP + 2 * PREP_ARR) + item * 4096 + ((nt * 4 + mt) * 64 + lane) * 4); }
    gt = WSB(float, WS_GT)[item];
    for (int c = 0; c < nsteps; ++c) {
        const size_t nitem = item + (c + 1 < nsteps ? 8 : 0);
        bf16x8 q2[4][2]; v2u nb2[4];
#pragma unroll
        for (int mt = 0; mt < 4; ++mt) { q2[mt][0] = *(const GAS bf16x8*)(WSB(bf16, WS_PREP) + nitem * 4096 + ((mt * 2 + 0) * 64 + lane) * 8); q2[mt][1] = *(const GAS bf16x8*)(WSB(bf16, WS_PREP) + nitem * 4096 + ((mt * 2 + 1) * 64 + lane) * 8);
            nb2[mt] = *(const GAS v2u*)(WSB(bf16, WS_PREP + 2 * PREP_ARR) + nitem * 4096 + ((nt * 4 + mt) * 64 + lane) * 4); }
        const float gt2 = WSB(float, WS_GT)[nitem];
        const bf16x8 sb0 = pack8(S[0], S[1]), sb1 = pack8(S[2], S[3]);
        *(GAS bf16x8*)(OBB(bf16, OB_SC) + item * 4096 + ((nt * 2 + 0) * 64 + lane) * 8) = sb0;
        *(GAS bf16x8*)(OBB(bf16, OB_SC) + item * 4096 + ((nt * 2 + 1) * 64 + lane) * 8) = sb1;
#pragma unroll
        for (int mt = 0; mt < 4; ++mt) {
            f32x4 acc; acc[0] = S[mt][0] * gt + bf2f(nb[mt].x & 0xffffu); acc[1] = S[mt][1] * gt + bf2f(nb[mt].x >> 16); acc[2] = S[mt][2] * gt + bf2f(nb[mt].y & 0xffffu); acc[3] = S[mt][3] * gt + bf2f(nb[mt].y >> 16);
            acc = mfma16(q[mt][0], sb0, acc); acc = mfma16(q[mt][1], sb1, acc); S[mt] = acc; }
#pragma unroll
        for (int mt = 0; mt < 4; ++mt) { q[mt][0] = q2[mt][0]; q[mt][1] = q2[mt][1]; nb[mt] = nb2[mt]; }
        gt = gt2; item = nitem;
    }
#pragma unroll
    for (int mt = 0; mt < 4; ++mt)
#pragma unroll
        for (int r = 0; r < 4; ++r) Sout[(16 * mt + 4 * fq + r) * 64 + 16 * nt + fr] = S[mt][r];
}
__device__ __forceinline__ void p3_phase(const Frame& F, const Args& A) {
    if (F.wave >= 4) return;
    if (F.bid < 8) scan_job(F, A, F.bid, 0, NCHP, nullptr, A.out + O_PSD + (size_t)F.bid * 4096);
    else for (int j = F.bid - 8; j < 256; j += F.G - 8) { const int b = j >> 3, h = j & 7; scan_job(F, A, h, NCHP + b, 1, A.in[2] + (size_t)j * 4096, A.out + O_SSD + (size_t)j * 4096); }
}

__device__ __forceinline__ void p4_phase(const Frame& F, const Args& A) {
    const int gw = F.bid * NWAVES + F.wave, NGW = F.G * NWAVES, lane = F.lane, fr = F.fr, fq = F.fq;
    for (int u = gw; u < NITEM * 4; u += NGW) {
        const size_t item = u >> 2; const int mt = u & 3, chunk = (int)(item >> 3), h = (int)(item & 7);
        const bf16x8 p0 = *(const GAS bf16x8*)(WSB(bf16, WS_PREP + PREP_ARR) + item * 4096 + ((mt * 2 + 0) * 64 + lane) * 8), p1 = *(const GAS bf16x8*)(WSB(bf16, WS_PREP + PREP_ARR) + item * 4096 + ((mt * 2 + 1) * 64 + lane) * 8);
        f32x4 o[4]; float ss[4] = {0.f, 0.f, 0.f, 0.f};
#pragma unroll
        for (int nt = 0; nt < 4; ++nt) {
            const bf16x8 s0 = *(const GAS bf16x8*)(OBB(bf16, OB_SC) + item * 4096 + ((nt * 2 + 0) * 64 + lane) * 8), s1 = *(const GAS bf16x8*)(OBB(bf16, OB_SC) + item * 4096 + ((nt * 2 + 1) * 64 + lane) * 8);
            const v2u om = *(const GAS v2u*)(WSB(bf16, WS_PREP + 3 * PREP_ARR) + item * 4096 + ((nt * 4 + mt) * 64 + lane) * 4);
            f32x4 acc; acc[0] = bf2f(om.x & 0xffffu); acc[1] = bf2f(om.x >> 16); acc[2] = bf2f(om.y & 0xffffu); acc[3] = bf2f(om.y >> 16);
            acc = mfma16(p0, s0, acc); acc = mfma16(p1, s1, acc); o[nt] = acc;
#pragma unroll
            for (int r = 0; r < 4; ++r) ss[r] += acc[r] * acc[r];
        }
#pragma unroll
        for (int r = 0; r < 4; ++r) { float s = ss[r]; s += __shfl_xor(s, 1); s += __shfl_xor(s, 2); s += __shfl_xor(s, 4); s += __shfl_xor(s, 8); ss[r] = rsqrtf(s * (1.f / 64.f) + NORM_EPS); }
#pragma unroll
        for (int r = 0; r < 4; ++r) { const int row = slot_row(chunk, 16 * mt + 4 * fq + r);
            if (row >= 0) {
#pragma unroll
                for (int nt = 0; nt < 4; ++nt) { const int v = 16 * nt + fr; const float z = bf2f(WSB(bf16, WS_PROJ)[(size_t)row * NPROJ + C_Z + h * 64 + v]);
                    OBB(bf16, OB_MIX)[(size_t)row * DM + h * 64 + v] = f2bf(o[nt][r] * ss[r] * A.in[13][v] * (z / (1.f + __expf(-z)))); } } }
    }
}

__device__ __forceinline__ void ln_rows(const Frame& F, const float* src, const float* g, const float* b, bf16* dstb, float* dstf) {
    const int gw = F.bid * NWAVES + F.wave, NGW = F.G * NWAVES, lane = F.lane;
    f32x4 lg[4], lb[4];
#pragma unroll
    for (int j = 0; j < 4; ++j) { lg[j] = ((const GAS f32x4*)g)[64 * j + lane]; lb[j] = ((const GAS f32x4*)b)[64 * j + lane]; }
    for (int m = gw; m < M2; m += NGW) {
        const GAS f32x4* xr = (const GAS f32x4*)(src + (size_t)m * DM) + lane;
        f32x4 v[4]; float s = 0.f;
#pragma unroll
        for (int j = 0; j < 4; ++j) { v[j] = xr[64 * j]; s += (v[j].x + v[j].y) + (v[j].z + v[j].w); }
        const float mean = wave_sum(s) * (1.f / DM); float s2 = 0.f;
#pragma unroll
        for (int j = 0; j < 4; ++j) { v[j] = v[j] - mean; s2 += (v[j].x * v[j].x + v[j].y * v[j].y) + (v[j].z * v[j].z + v[j].w * v[j].w); }
        const float rstd = 1.f / sqrtf(wave_sum(s2) * (1.f / DM) + LN_EPS);
#pragma unroll
        for (int j = 0; j < 4; ++j) { v[j] = v[j] * rstd * lg[j] + lb[j];
            if (dstb) ((GAS unsigned long long*)(dstb + (size_t)m * DM) + lane)[64 * j] = (unsigned long long)pk2(v[j].x, v[j].y) | ((unsigned long long)pk2(v[j].z, v[j].w) << 32);
            else ((GAS f32x4*)(dstf + (size_t)m * DM) + lane)[64 * j] = v[j]; }
    }
}

__global__ void __launch_bounds__(NTHR, 2) mk_fwd(Args args) {
    extern __shared__ __attribute__((aligned(16))) unsigned char lds[];
    Frame F;
    F.lds = (LAS unsigned char*)lds;
    F.tid = threadIdx.x; F.lane = F.tid & 63; F.wave = __builtin_amdgcn_readfirstlane(F.tid >> 6); F.fr = F.lane & 15; F.fq = F.lane >> 4;
    F.G = gridDim.x; F.bid = blockIdx.x;
    const Args& A = args; unsigned char* ws = args.ws;
    for (int u = F.tid; u < (LDS_BYTES - LDSCTL_OFF) / 4; u += NTHR) ((LAS unsigned*)(F.lds + LDSCTL_OFF))[u] = 0u;
    __syncthreads();
    XcdBarrier bar; bar.bar = (unsigned*)(ws + WS_CTL) + CW_BAR; bar.x = 0; bar.st = nullptr;
    if (N_LAUNCHES == 1) bar = xcd_barrier_post((unsigned*)(ws + WS_CTL) + CW_BAR, (volatile LAS unsigned*)(F.lds + MISC_OFF) + 8);
    const int lo = args.ph_lo, hi = args.ph_hi;
#ifndef PHASE_MASK
#define PHASE_MASK 0x3ff
#endif
#define IN(k) (((PHASE_MASK >> (k)) & 1) && lo <= (k) && (k) < hi)
#define SEAM(k) do { if (IN(k) && IN((k) + 1)) xcd_barrier(bar); } while (0)

    if (IN(0)) { p0_prologue(F, A); } SEAM(0);
    if (IN(1)) {
        pg8::Gemm g{WSB(bf16, WS_H), WSB(bf16, WS_WIN), MP, NPROJ, DM}; pg8::StaticOrder S; S.init(MP, NPROJ, F.G, F.bid);
        pg8::EpiBf16<0> E{WSB(bf16, WS_PROJ), NPROJ};
        pg8::gemm_phase<pg8::EpiBf16<0>, pg8::StaticOrder, true, true>(F.lds, g, S, E);
    } SEAM(1);
    if (IN(2)) { p2_phase(F, A); } SEAM(2);
    if (IN(3)) { p3_phase(F, A); } SEAM(3);
    if (IN(4)) { p4_phase(F, A); } SEAM(4);
    if (IN(5)) {
        pg8::Gemm g{OBB(bf16, OB_MIX) + (size_t)ROW0 * DM, WSB(bf16, WS_WO), M2, DM, DM}; pg8::StaticOrder S; S.init(M2, DM, F.G, F.bid);
        pg8::EpiResF32 E{WSB(float, WS_Z1), DM, WSB(bf16, WS_H) + (size_t)ROW0 * DM, DM, DEEP_ALPHA};
        pg8::gemm_phase<pg8::EpiResF32, pg8::StaticOrder, true, true>(F.lds, g, S, E);
    } SEAM(5);
    if (IN(6)) { ln_rows(F, WSB(float, WS_Z1), A.in[17], A.in[18], WSB(bf16, WS_H), nullptr); } SEAM(6);
    if (IN(7)) {
        pg8::Gemm g{WSB(bf16, WS_H), WSB(bf16, WS_W1), M2, DFF, DM}; pg8::StaticOrder S; S.init(M2, DFF, F.G, F.bid);
        pg8::EpiBf16<2> E{WSB(bf16, WS_HID), DFF};
        pg8::gemm_phase<pg8::EpiBf16<2>, pg8::StaticOrder, true, true>(F.lds, g, S, E);
    } SEAM(7);
    if (IN(8)) {
        pg8::Gemm g{WSB(bf16, WS_HID), WSB(bf16, WS_W2), M2, DM, DFF}; pg8::StaticOrder S; S.init(M2, DM, F.G, F.bid);
        pg8::EpiResF32 E{A.out + O_Y, DM, WSB(bf16, WS_H), DM, DEEP_ALPHA};
        pg8::gemm_phase<pg8::EpiResF32, pg8::StaticOrder, true, true>(F.lds, g, S, E);
    } SEAM(8);
    if (IN(9)) { ln_rows(F, A.out + O_Y, A.in[21], A.in[22], nullptr, A.out + O_Y); }
#undef IN
#undef SEAM
}

extern "C" void kernel_launch(void* const* d_in, const int* in_sizes, int n_in, void* d_out, int out_size, void* d_ws, size_t ws_size, hipStream_t stream) {
    static int grid = 0;
    if (grid == 0) {
        if (n_in != 23 || out_size != (int)O_END || ws_size < WS_END) { fprintf(stderr, "kernel_launch: unexpected problem (n_in %d, out %d, ws %zu); nothing launched\n", n_in, out_size, ws_size); grid = -1; return; }
        int dev = 0, cus = 0, per_cu = 0;
        if (hipGetDevice(&dev) != hipSuccess || hipDeviceGetAttribute(&cus, hipDeviceAttributeMultiprocessorCount, dev) != hipSuccess) { fprintf(stderr, "kernel_launch: device query failed\n"); grid = -1; return; }
        if (hipFuncSetAttribute((const void*)mk_fwd, hipFuncAttributeMaxDynamicSharedMemorySize, LDS_BYTES) != hipSuccess) { fprintf(stderr, "kernel_launch: hipFuncSetAttribute failed\n"); grid = -1; return; }
        if (hipOccupancyMaxActiveBlocksPerMultiprocessor(&per_cu, (const void*)mk_fwd, NTHR, LDS_BYTES) != hipSuccess || per_cu < 1) fprintf(stderr, "kernel_launch: occupancy query reports %d blocks per CU\n", per_cu);
        (void)hipGetLastError();
        grid = cus;
    }
    if (grid < 0) return;
    (void)hipMemsetAsync((char*)d_ws + WS_CTL, 0, CTL_ZERO_BYTES, stream);
    Args a{};
    for (int i = 0; i < 23; ++i) a.in[i] = (const float*)d_in[i];
    a.out = (float*)d_out; a.ws = (unsigned char*)d_ws;
    if (N_LAUNCHES == 1) { a.ph_lo = 0; a.ph_hi = NPH; a.li = 0; hipLaunchKernelGGL(mk_fwd, dim3(grid), dim3(NTHR), LDS_BYTES, stream, a); }
    else for (int li = 0; li < NPH; ++li) { a.ph_lo = li; a.ph_hi = li + 1; a.li = li; hipLaunchKernelGGL(mk_fwd, dim3(grid), dim3(NTHR), LDS_BYTES, stream, a); }
    const hipError_t le = hipPeekAtLastError();
    if (le != hipSuccess) fprintf(stderr, "kernel_launch: launch failed: %s\n", hipGetErrorName(le));
}
```

```cpp
#include <hip/hip_runtime.h>
#include <cstdio>
#include <cstdint>
#define MK_N_LAUNCHES 1
#include <cmath>
namespace pg8 {
#define PG8_LAS __attribute__((address_space(3)))
typedef unsigned short bf16_t;
typedef short bf16x8 __attribute__((ext_vector_type(8)));
typedef float f32x4 __attribute__((ext_vector_type(4)));
typedef unsigned u32x4 __attribute__((ext_vector_type(4)));
constexpr int BM = 256, BK = 64, HALF = 128, HTB = HALF * BK * 2  , STAGE_BYTES = 8 * HTB, NXCD = 8, WGM = 8;

__host__ __device__ __forceinline__ int lds_byte(int r, int c) { const int st = (r >> 4) * 2 + (c >> 5), rr = r & 15, cc = c & 31, ob = rr * 64 + cc * 2; return st * 1024 + (ob ^ (((ob >> 9) & 1) << 5)); }
__host__ __device__ __forceinline__ void stage_rc(int b, int& R, int& C) { const int st = b / 1024, sb = b % 1024, swz = sb ^ (((sb >> 9) & 1) << 5); R = (st >> 1) * 16 + swz / 64; C = (st & 1) * 32 + (swz % 64) / 2; }
__host__ __device__ __forceinline__ int perm32(int rho) { const int n = rho >> 4, i = rho & 15; return 8 * (i >> 2) + 4 * n + (i & 3); }

struct Unit { int pm, pn; };
struct Gemm { const bf16_t* A; const bf16_t* Bt; int M, N, K; };

struct StaticOrder {
    int nM, nN, nwg, G, c;
    __host__ __device__ void init(int M, int N, int G_, int c_) { nM = M / BM; nN = N / BM; nwg = nM * nN; G = G_; c = c_; }
    __host__ __device__ bool next(int i, Unit& u) const {
        const long L = (long)i * G + c; if (L >= nwg) return false;
        int wgid = (int)L; { const int q = nwg / NXCD, r = nwg % NXCD, xcd = wgid % NXCD, off = wgid / NXCD; wgid = (xcd < r ? xcd * (q + 1) : r * (q + 1) + (xcd - r) * q) + off; }
        const int nig = WGM * nN, gid = wgid / nig, fm = gid * WGM, gsz = (nM - fm) < WGM ? (nM - fm) : WGM;
        u.pm = fm + ((wgid % nig) % gsz); u.pn = (wgid % nig) / gsz; return true;
    }
    __device__ __forceinline__ void a_ready(const Unit&) const {}
    __device__ __forceinline__ void done(const Unit&) const {}
};
__device__ __forceinline__ unsigned cvt_pk_bf16(float lo, float hi) { unsigned r; asm volatile("v_cvt_pk_bf16_f32 %0, %1, %2" : "=v"(r) : "v"(lo), "v"(hi)); return r; }
template <int ACT> struct EpiBf16 {
    static constexpr bool PERM = true, AFTER_DRAIN = false;
    bf16_t* O; int ldc;
    __device__ __forceinline__ void operator()(const f32x4 (&acc)[2][2][4][2], const Unit& u, int wr, int wc, int fr, int fq) const {
        const int row0 = u.pm * BM + wr * 64 + fr, col0 = u.pn * BM + wc * 32 + 8 * fq;
#pragma unroll
        for (int ai = 0; ai < 2; ++ai)
#pragma unroll
            for (int m = 0; m < 4; ++m) { bf16_t* rowp = O + (size_t)(row0 + ai * HALF + m * 16) * ldc + col0;
#pragma unroll
                for (int bj = 0; bj < 2; ++bj) { f32x4 v0 = acc[ai][bj][m][0], v1 = acc[ai][bj][m][1];
                    if (ACT == 2) {
#pragma unroll
                        for (int e = 0; e < 4; ++e) { const float a = fmaxf(v0[e], 0.f), b = fmaxf(v1[e], 0.f); v0[e] = a * a; v1[e] = b * b; } }
                    u32x4 w; w.x = cvt_pk_bf16(v0[0], v0[1]); w.y = cvt_pk_bf16(v0[2], v0[3]); w.z = cvt_pk_bf16(v1[0], v1[1]); w.w = cvt_pk_bf16(v1[2], v1[3]);
                    *(u32x4*)(rowp + bj * HALF) = w; } }
    }
};
struct EpiResF32 {
    static constexpr bool PERM = false, AFTER_DRAIN = false;
    float* C; int ldc; const bf16_t* res; int ldr; float alpha;
    __device__ __forceinline__ void operator()(const f32x4 (&acc)[2][2][4][2], const Unit& u, int wr, int wc, int fr, int fq) const {
        typedef unsigned u32x2 __attribute__((ext_vector_type(2)));
        const int row0 = u.pm * BM + wr * 64 + fr, col0 = u.pn * BM + wc * 32 + 4 * fq;
#pragma unroll
        for (int ai = 0; ai < 2; ++ai)
#pragma unroll
            for (int m = 0; m < 4; ++m) { const int row = row0 + ai * HALF + m * 16; float* rowp = C + (size_t)row * ldc + col0; const bf16_t* rp = res + (size_t)row * ldr + col0;
#pragma unroll
                for (int bj = 0; bj < 2; ++bj)
#pragma unroll
                    for (int n = 0; n < 2; ++n) { const u32x2 rr = *(const u32x2*)(rp + bj * HALF + n * 16);
                        f32x4 o; o[0] = __uint_as_float(rr.x << 16); o[1] = __uint_as_float(rr.x & 0xffff0000u); o[2] = __uint_as_float(rr.y << 16); o[3] = __uint_as_float(rr.y & 0xffff0000u);
                        *(f32x4*)(rowp + bj * HALF + n * 16) = o * alpha + acc[ai][bj][m][n]; } }
    }
};

template <class Epi, class Sched, bool ALIGN_EPI = false, bool SP2 = false>
__device__ __forceinline__ void gemm_phase(PG8_LAS unsigned char* lds, const Gemm g, const Sched& S, const Epi& E) {
    const int tid = threadIdx.x, wid = __builtin_amdgcn_readfirstlane(tid >> 6), lane = tid & 63, wr = wid >> 2, wc = wid & 3, fr = lane & 15, fq = lane >> 4;
    const int K = g.K, nt = K / BK;
    unsigned voffA[2], voffB[2];
#pragma unroll
    for (int i = 0; i < 2; ++i) { int R, C; stage_rc(tid * 16 + i * 8192, R, C); const int Rb = Epi::PERM ? ((R & ~31) + perm32(R & 31)) : R;
        voffA[i] = (unsigned)(R * K + C) * 2u; voffB[i] = (unsigned)(Rb * K + C) * 2u; }
    const size_t kstep = (size_t)(BK * 2);
    const size_t hstep = (size_t)HALF * K * 2;
    const size_t tstep = 2 * hstep;
    const unsigned ldsw = (unsigned)wid * 1024u;
    const int aoff = lds_byte(wr * 64 + fr, fq * 8), boff = lds_byte(wc * 32 + fr, fq * 8);
#define PG8_SA(b, h) (((b) * 2 + (h)) * HTB)
#define PG8_SB(b, h) ((4 + (b) * 2 + (h)) * HTB)
#define PG8_STAGE(bufoff, gbase, voff) do { _Pragma("unroll") for (int _i = 0; _i < 2; ++_i) \
        __builtin_amdgcn_global_load_lds((const unsigned*)((const char*)(gbase) + (voff)[_i]), (PG8_LAS unsigned*)(lds + (bufoff) + ldsw + _i * 8192), 16, 0, 0); } while (0)
#define PG8_LDA(dst, b, h) do { _Pragma("unroll") for (int m = 0; m < 4; ++m) _Pragma("unroll") for (int k = 0; k < 2; ++k) dst[m][k] = *(const PG8_LAS bf16x8*)(lds + PG8_SA(b, h) + aoff + m * 2048 + k * 1024); } while (0)
#define PG8_LDB(dst, b, h) do { _Pragma("unroll") for (int n = 0; n < 2; ++n) _Pragma("unroll") for (int k = 0; k < 2; ++k) dst[n][k] = *(const PG8_LAS bf16x8*)(lds + PG8_SB(b, h) + boff + n * 2048 + k * 1024); } while (0)
#define PG8_MMA(ai, bj, At, Bt) do { __builtin_amdgcn_s_setprio(1); _Pragma("unroll") for (int m = 0; m < 4; ++m) _Pragma("unroll") for (int n = 0; n < 2; ++n) _Pragma("unroll") for (int k = 0; k < 2; ++k) \
        acc[ai][bj][m][n] = __builtin_amdgcn_mfma_f32_16x16x32_bf16(Bt[n][k], At[m][k], acc[ai][bj][m][n], 0, 0, 0); __builtin_amdgcn_s_setprio(0); } while (0)
#define PG8_WAIT_V(n) asm volatile("s_waitcnt vmcnt(" #n ")" ::: "memory")
#define PG8_WAIT_L(n) asm volatile("s_waitcnt lgkmcnt(" #n ")" ::: "memory")
#define PG8_BAR __builtin_amdgcn_s_barrier()
#define PG8_SCHED __builtin_amdgcn_sched_barrier(0)
    Unit cur, nxt; int ui = 0;
    if (!S.next(0, cur)) return;
    f32x4 acc[2][2][4][2];
#pragma unroll
    for (int a = 0; a < 2; ++a)
#pragma unroll
        for (int b = 0; b < 2; ++b)
#pragma unroll
            for (int m = 0; m < 4; ++m)
#pragma unroll
                for (int n = 0; n < 2; ++n) acc[a][b][m][n] = (f32x4){0.f, 0.f, 0.f, 0.f};
    bf16x8 At[4][2], B0[2][2], B1[2][2];
    const char* cA = (const char*)g.A + (size_t)cur.pm * tstep; const char* cB = (const char*)g.Bt + (size_t)cur.pn * tstep;
    S.a_ready(cur);
    if constexpr (SP2) {
        PG8_STAGE(PG8_SB(0, 0), cB, voffB); PG8_STAGE(PG8_SB(0, 1), cB + hstep, voffB); PG8_STAGE(PG8_SA(0, 0), cA, voffA); PG8_STAGE(PG8_SA(0, 1), cA + hstep, voffA);
        if (wr == 1) PG8_BAR;
        PG8_WAIT_V(2); PG8_BAR;
        PG8_STAGE(PG8_SB(1, 0), cB + kstep, voffB); PG8_STAGE(PG8_SA(1, 0), cA + kstep, voffA); PG8_STAGE(PG8_SB(1, 1), cB + hstep + kstep, voffB);
        PG8_WAIT_V(6); PG8_BAR;
    } else {
        PG8_STAGE(PG8_SB(0, 0), cB, voffB); PG8_STAGE(PG8_SA(0, 0), cA, voffA); PG8_STAGE(PG8_SB(0, 1), cB + hstep, voffB); PG8_STAGE(PG8_SA(0, 1), cA + hstep, voffA);
        if (wr == 1) PG8_BAR;
        PG8_WAIT_V(4); PG8_BAR;
        PG8_STAGE(PG8_SB(1, 0), cB + kstep, voffB); PG8_STAGE(PG8_SA(1, 0), cA + kstep, voffA); PG8_STAGE(PG8_SB(1, 1), cB + hstep + kstep, voffB);
        PG8_WAIT_V(6); PG8_BAR;
    }
    for (;;) {
        const bool has_next = S.next(ui + 1, nxt);
        const char* nA = has_next ? (const char*)g.A + (size_t)nxt.pm * tstep : cA; const char* nB = has_next ? (const char*)g.Bt + (size_t)nxt.pn * tstep : cB;
        for (int t = 0; t < nt; t += 2) {
            const bool last = (t == nt - 2);
            const char* a1 = cA + (size_t)(t + 1) * kstep;
            const char* a2 = last ? nA : cA + (size_t)(t + 2) * kstep; const char* b2 = last ? nB : cB + (size_t)(t + 2) * kstep;
            const char* a3 = a2 + kstep; const char* b3 = b2 + kstep;
            if (last && has_next) S.a_ready(nxt);
            if constexpr (SP2) {
            PG8_LDB(B0, 0, 0); PG8_LDB(B1, 0, 1); PG8_SCHED; PG8_LDA(At, 0, 0); PG8_STAGE(PG8_SA(1, 1), a1 + hstep, voffA);
            PG8_WAIT_V(8); PG8_WAIT_L(0); PG8_BAR; PG8_MMA(0, 0, At, B0); PG8_MMA(0, 1, At, B1); PG8_BAR; PG8_SCHED;
            PG8_LDA(At, 0, 1); PG8_STAGE(PG8_SB(0, 0), b2, voffB); PG8_STAGE(PG8_SB(0, 1), b2 + hstep, voffB); PG8_STAGE(PG8_SA(0, 0), a2, voffA);
            PG8_WAIT_V(8); PG8_WAIT_L(0); PG8_BAR; PG8_MMA(1, 0, At, B0); PG8_MMA(1, 1, At, B1); PG8_BAR; PG8_SCHED;
            PG8_LDB(B0, 1, 0); PG8_LDB(B1, 1, 1); PG8_SCHED; PG8_LDA(At, 1, 0); PG8_STAGE(PG8_SA(0, 1), a2 + hstep, voffA);
            PG8_WAIT_V(8); PG8_WAIT_L(0); PG8_BAR; PG8_MMA(0, 0, At, B0); PG8_MMA(0, 1, At, B1); PG8_BAR; PG8_SCHED;
            PG8_LDA(At, 1, 1); PG8_STAGE(PG8_SB(1, 0), b3, voffB); PG8_STAGE(PG8_SB(1, 1), b3 + hstep, voffB); PG8_STAGE(PG8_SA(1, 0), a3, voffA);
            PG8_WAIT_V(8); PG8_WAIT_L(0); PG8_BAR; PG8_MMA(1, 0, At, B0); PG8_MMA(1, 1, At, B1); PG8_BAR; PG8_SCHED;
            } else {
            PG8_LDB(B0, 0, 0); PG8_SCHED; PG8_LDA(At, 0, 0); PG8_STAGE(PG8_SA(1, 1), a1 + hstep, voffA);
            PG8_WAIT_L(8); PG8_BAR; PG8_WAIT_L(0); PG8_MMA(0, 0, At, B0); PG8_BAR; PG8_SCHED;
            PG8_LDB(B1, 0, 1); PG8_STAGE(PG8_SB(0, 0), b2, voffB);
            PG8_BAR; PG8_WAIT_L(0); PG8_MMA(0, 1, At, B1); PG8_BAR;
            PG8_LDA(At, 0, 1); PG8_STAGE(PG8_SA(0, 0), a2, voffA);
            PG8_BAR; PG8_WAIT_L(0); PG8_MMA(1, 0, At, B0); PG8_BAR; PG8_SCHED;
            PG8_STAGE(PG8_SB(0, 1), b2 + hstep, voffB);
            PG8_WAIT_V(6); PG8_BAR; PG8_MMA(1, 1, At, B1); PG8_BAR;
            PG8_LDB(B0, 1, 0); PG8_SCHED; PG8_LDA(At, 1, 0); PG8_STAGE(PG8_SA(0, 1), a2 + hstep, voffA);
            PG8_WAIT_L(8); PG8_BAR; PG8_WAIT_L(0); PG8_MMA(0, 0, At, B0); PG8_BAR; PG8_SCHED;
            PG8_LDB(B1, 1, 1); PG8_STAGE(PG8_SB(1, 0), b3, voffB);
            PG8_BAR; PG8_WAIT_L(0); PG8_MMA(0, 1, At, B1); PG8_BAR;
            PG8_LDA(At, 1, 1); PG8_STAGE(PG8_SA(1, 0), a3, voffA);
            PG8_BAR; PG8_WAIT_L(0); PG8_MMA(1, 0, At, B0); PG8_BAR; PG8_SCHED;
            PG8_STAGE(PG8_SB(1, 1), b3 + hstep, voffB);
            PG8_WAIT_V(6); PG8_BAR; PG8_MMA(1, 1, At, B1); PG8_BAR;
            }
        }
        if constexpr (ALIGN_EPI) { if (wr == 0) PG8_BAR; }
        if constexpr (!Epi::AFTER_DRAIN) { E(acc, cur, wr, wc, fr, fq); S.done(cur); }
        if (!has_next) break;
#pragma unroll
        for (int a = 0; a < 2; ++a)
#pragma unroll
            for (int b = 0; b < 2; ++b)
#pragma unroll
                for (int m = 0; m < 4; ++m)
#pragma unroll
                    for (int n = 0; n < 2; ++n) acc[a][b][m][n] = (f32x4){0.f, 0.f, 0.f, 0.f};
        cur = nxt; cA = nA; cB = nB; ++ui;
        if constexpr (ALIGN_EPI) { if (wr == 1) PG8_BAR; }
    }
    PG8_WAIT_V(0);
    if constexpr (!ALIGN_EPI) { if (wr == 0) PG8_BAR; }
    PG8_BAR;
    if constexpr (Epi::AFTER_DRAIN) { E.fused(acc, cur, wr, wc, fr, fq, lds, wid, lane); S.done(cur); }
#undef PG8_SA
#undef PG8_SB
#undef PG8_STAGE
#undef PG8_LDA
#undef PG8_LDB
#undef PG8_MMA
#undef PG8_WAIT_V
#undef PG8_WAIT_L
#undef PG8_BAR
#undef PG8_SCHED
}
}
#define GAS __attribute__((address_space(1)))
#define LAS __attribute__((address_space(3)))
#define XB_TMO      128
#define XB_XCNT(j)  (256  + 64 * (j))
#define XB_XSUB(j)  (1280 + 64 * (j))
#define XB_XGEN(j)  (2304 + 64 * (j))
#define XB_TOP      3328
#define XB_TOPGEN   3392
#define XCD_BAR_WORDS 3456
#define XB_SPIN_CAP (1u << 18)

__device__ __forceinline__ unsigned xb_ld(unsigned* p)              { return __hip_atomic_load(p, __ATOMIC_RELAXED, __HIP_MEMORY_SCOPE_AGENT); }
__device__ __forceinline__ unsigned xb_add(unsigned* p, unsigned v) { return __hip_atomic_fetch_add(p, v, __ATOMIC_RELAXED, __HIP_MEMORY_SCOPE_AGENT); }
__device__ __forceinline__ unsigned xb_xcc_id() { return (unsigned)__builtin_amdgcn_s_getreg((3 << 11) | 20) & 0xFu; }
#define XB_SPIN(cond, bar) do { unsigned _sp = 0; while (cond) { __builtin_amdgcn_s_sleep(1); \
    if ((++_sp & 255u) == 0u) { if (xb_ld(&(bar)[XB_TMO])) break; if (_sp > XB_SPIN_CAP) { atomicAdd(&(bar)[XB_TMO], 1u); break; } } } } while (0)

struct XcdBarrier {
    unsigned* bar; unsigned x;
    volatile LAS unsigned* st;
};

__device__ __forceinline__ XcdBarrier xcd_barrier_post(unsigned* bar, volatile LAS unsigned* st) {
    XcdBarrier b; b.bar = bar; b.x = xb_xcc_id(); b.st = st;
    if (threadIdx.x == 0) (void)xb_add(&bar[XB_XCNT(b.x)], 1u);
    return b;
}
__device__ __forceinline__ void xcd_barrier_complete(unsigned* bar, unsigned x, unsigned& nloc, unsigned& nx) {
    const unsigned G = gridDim.x * gridDim.y * gridDim.z;
    unsigned sum, cnt, mine, sp = 0u;
    for (;;) {
        sum = 0u; cnt = 0u; mine = 0u;
#pragma unroll
        for (unsigned j = 0; j < 16; ++j) { const unsigned c = xb_ld(&bar[XB_XCNT(j)]); sum += c; cnt += (c > 0u) ? 1u : 0u; mine = (j == x) ? c : mine; }
        if (sum == G) break;
        __builtin_amdgcn_s_sleep(1);
        if ((++sp & 255u) == 0u) { if (xb_ld(&bar[XB_TMO])) break; if (sp > XB_SPIN_CAP) { atomicAdd(&bar[XB_TMO], 1u); break; } }
    }
    nloc = mine > 0u ? mine : 1u; nx = cnt > 0u ? cnt : 1u;
}

__device__ __forceinline__ void xcd_barrier(const XcdBarrier& b) {
    asm volatile("s_waitcnt vmcnt(0)" ::: "memory");
    __syncthreads();
    if (threadIdx.x == 0) {
        unsigned* bar = b.bar;
        __builtin_amdgcn_s_waitcnt(0);
        unsigned nloc = b.st[0], nx = b.st[1];
        if (nloc == 0u) { xcd_barrier_complete(bar, b.x, nloc, nx); b.st[0] = nloc; b.st[1] = nx; }
        const unsigned old = xb_add(&bar[XB_XSUB(b.x)], 1u);
        const unsigned gen = old / nloc;
        if (old + 1u == (gen + 1u) * nloc) {
            __builtin_amdgcn_fence(__ATOMIC_RELEASE, "agent");
            asm volatile("s_waitcnt vmcnt(0)" ::: "memory");
            const unsigned og = xb_add(&bar[XB_TOP], 1u);
            const unsigned tg = og / nx;
            if (og + 1u == (tg + 1u) * nx) xb_add(&bar[XB_TOPGEN], 1u);
            else XB_SPIN(xb_ld(&bar[XB_TOPGEN]) == tg, bar);
            __builtin_amdgcn_fence(__ATOMIC_ACQUIRE, "agent");
            xb_add(&bar[XB_XGEN(b.x)], 1u);
            asm volatile("s_waitcnt vmcnt(0)" ::: "memory");
        } else {
            XB_SPIN(xb_ld(&bar[XB_XGEN(b.x)]) == gen, bar);
            __builtin_amdgcn_fence(__ATOMIC_ACQUIRE, "agent");
            asm volatile("s_waitcnt vmcnt(0)" ::: "memory");
        }
    }
    __syncthreads();
}

#define GAS __attribute__((address_space(1)))
#define LAS __attribute__((address_space(3)))
typedef unsigned short bf16;
typedef unsigned v4u __attribute__((ext_vector_type(4)));
typedef unsigned v2u __attribute__((ext_vector_type(2)));
typedef float f32x4 __attribute__((ext_vector_type(4)));
typedef short bf16x8 __attribute__((ext_vector_type(8)));

constexpr int NWAVES = 8, NTHR = 512;
#ifndef MK_N_LAUNCHES
#define MK_N_LAUNCHES 1
#endif
constexpr int NPH = 10;
constexpr int N_LAUNCHES = MK_N_LAUNCHES;

constexpr int DM = 1024, NPR = 16400  , NTOK = 17424, MP = 17664  , M2 = 17408  , ROW0 = 16;
constexpr int NPROJ = 2816  , WIN_LD = 2832, DFF = 4096;
constexpr int NCHP = 257, NCH = 289, NITEM = NCH * 8;
constexpr int C_K = 512, C_V = 1024, C_Z = 1536, C_SQ = 2048, C_SK = 2560, C_SV = 2688;
constexpr float LN_EPS = 1e-5f, NORM_EPS = 1e-6f, DEEP_ALPHA = 1.189207115002721f;
constexpr size_t O_Y = 0, O_PSD = 17825792, O_PSC = 17858560, O_PK = 17863168, O_PV = 17879552, O_SSD = 17895936, O_SSC = 18944512, O_SK = 19091968, O_SV = 19223040, O_END = 19354112;
constexpr size_t OB_MIX = 0, OB_SC = 35684352, OB_GB = 54624256;
constexpr size_t MiB = 1u << 20;
constexpr size_t WS_CTL = 0, CTL_ZERO_BYTES = 64 * 1024, WS_GT = 1 * MiB, WS_WIN = 4 * MiB, WS_WO = 10 * MiB, WS_W1 = 12 * MiB, WS_W2 = 20 * MiB, WS_H = 28 * MiB, WS_BIG = 63 * MiB;
constexpr size_t WS_PROJ = WS_BIG, WS_PREP = 158 * MiB, PREP_ARR = (size_t)NITEM * 8192;
constexpr size_t WS_Z1 = WS_BIG, WS_HID = WS_BIG, WS_END = 232 * MiB;
static_assert(WS_H + (size_t)MP * DM * 2 <= WS_BIG && WS_PROJ + (size_t)MP * NPROJ * 2 <= WS_PREP && WS_PREP + 4 * PREP_ARR <= WS_END && WS_HID + (size_t)M2 * DFF * 2 <= WS_END, "ws map");
static_assert(OB_GB + (size_t)NTOK * 64 <= (size_t)M2 * DM * 4 && OB_SC + (size_t)NITEM * 8192 <= OB_GB && (size_t)NTOK * DM * 2 <= OB_SC, "d_out scratch map");
constexpr int CW_BAR = 4096;
constexpr int RING_BYTES = 131072, LDSCTL_OFF = RING_BYTES, MISC_OFF = LDSCTL_OFF + 320, LDS_BYTES = 147456;

__device__ __forceinline__ float bf2f(unsigned h) { return __uint_as_float(h << 16); }
typedef float f32x2_t __attribute__((ext_vector_type(2))); typedef __bf16 bf16x2_t __attribute__((ext_vector_type(2)));
__device__ __forceinline__ unsigned pk2(float lo, float hi) { const f32x2_t v = {lo, hi}; const bf16x2_t b = __builtin_convertvector(v, bf16x2_t); return __builtin_bit_cast(unsigned, b); }
__device__ __forceinline__ bf16 f2bf(float f) { return (bf16)(pk2(f, 0.f) & 0xffffu); }
__device__ __forceinline__ void unpack8(const v4u r, float (&x)[8]) {
    x[0] = __uint_as_float(r.x << 16); x[1] = __uint_as_float(r.x & 0xffff0000u); x[2] = __uint_as_float(r.y << 16); x[3] = __uint_as_float(r.y & 0xffff0000u);
    x[4] = __uint_as_float(r.z << 16); x[5] = __uint_as_float(r.z & 0xffff0000u); x[6] = __uint_as_float(r.w << 16); x[7] = __uint_as_float(r.w & 0xffff0000u);
}
__device__ __forceinline__ bf16x8 pack8(const f32x4 a, const f32x4 b) {
    v4u w; w.x = pk2(a[0], a[1]); w.y = pk2(a[2], a[3]); w.z = pk2(b[0], b[1]); w.w = pk2(b[2], b[3]); return __builtin_bit_cast(bf16x8, w);
}
__device__ __forceinline__ f32x4 mfma16(bf16x8 a, bf16x8 b, f32x4 c) { return __builtin_amdgcn_mfma_f32_16x16x32_bf16(a, b, c, 0, 0, 0); }
__device__ __forceinline__ float wave_sum(float v) {
#pragma unroll
    for (int o = 1; o < 64; o <<= 1) v += __shfl_xor(v, o);
    return v;
}

struct Args { const float* in[23]; float* out; unsigned char* ws; int ph_lo, ph_hi, li, pad; };

struct Frame { LAS unsigned char* lds; int tid, lane, wave, fr, fq, G, bid; };
#define WSB(T, off) ((T*)(A.ws + (off)))
#define OBB(T, off) ((T*)((unsigned char*)A.out + (off)))


__device__ __forceinline__ int slot_row(int chunk, int i) {
    if (chunk < NCHP) return 64 * chunk + i - 48;
    return i >= 32 ? NPR + 32 * (chunk - NCHP) + (i - 32) : -1;
}

__device__ __forceinline__ void p0_transpose_item(const float* W, int ldw, int srccol0, bf16* WT, int K, int dstrow0, LAS float* scr, int k0, int lane) {
#pragma unroll 8
    for (int i = 0; i < 32; ++i) { const int kk = 2 * i + (lane >> 5); scr[kk * 33 + (lane & 31)] = W[(size_t)(k0 + kk) * ldw + srccol0 + (lane & 31)]; }
    asm volatile("s_waitcnt lgkmcnt(0)" ::: "memory");
    const int c = lane & 7;
#pragma unroll
    for (int j = 0; j < 4; ++j) { const int n = (lane >> 3) + 8 * j; const LAS float* s = scr + (8 * c) * 33 + n;
        v4u o; o.x = pk2(s[0 * 33], s[1 * 33]); o.y = pk2(s[2 * 33], s[3 * 33]); o.z = pk2(s[4 * 33], s[5 * 33]); o.w = pk2(s[6 * 33], s[7 * 33]);
        *(GAS v4u*)(WT + (size_t)(dstrow0 + n) * K + k0 + 8 * c) = o; }
    asm volatile("s_waitcnt lgkmcnt(0)" ::: "memory");
}

__device__ __forceinline__ void p0_prologue(const Frame& F, const Args& A) {
    const int gw = F.bid * NWAVES + F.wave, NGW = F.G * NWAVES, lane = F.lane;
    {
        LAS float* scr = (LAS float*)(F.lds + F.wave * 16384);
        constexpr int I_IN = 16 * 88, I_O = 16 * 32, I_1 = 16 * 128, I_2 = 64 * 32, NITEMS = I_IN + I_O + I_1 + I_2;
        for (int it = gw; it < NITEMS; it += NGW) {
            int r = it;
            if (r < I_IN) { const int kb = r / 88, nb = r % 88, n0 = 32 * nb; p0_transpose_item(A.in[9], WIN_LD, n0 < 2048 ? n0 : n0 + 16, WSB(bf16, WS_WIN), DM, n0, scr, 64 * kb, lane); continue; } r -= I_IN;
            if (r < I_O) { const int kb = r / 32, nb = r % 32; p0_transpose_item(A.in[16], DM, 32 * nb, WSB(bf16, WS_WO), DM, 32 * nb, scr, 64 * kb, lane); continue; } r -= I_O;
            if (r < I_1) { const int kb = r / 128, nb = r % 128; p0_transpose_item(A.in[19], DFF, 32 * nb, WSB(bf16, WS_W1), DM, 32 * nb, scr, 64 * kb, lane); continue; } r -= I_1;
            { const int kb = r / 32, nb = r % 32; p0_transpose_item(A.in[20], DM, 32 * nb, WSB(bf16, WS_W2), DFF, 32 * nb, scr, 64 * kb, lane); }
        }
    }
    __syncthreads();
    LAS float* wab = (LAS float*)F.lds;
    for (int idx = F.tid; idx < 16384; idx += NTHR) { const int k = idx >> 4, e = idx & 15; wab[e * 1024 + k] = A.in[9][(size_t)k * WIN_LD + 2048 + e]; }
    __syncthreads();
    f32x4 lg[4], lb[4];
#pragma unroll
    for (int j = 0; j < 4; ++j) { lg[j] = ((const GAS f32x4*)A.in[7])[64 * j + lane]; lb[j] = ((const GAS f32x4*)A.in[8])[64 * j + lane]; }
    const float hp_a = (lane < 8) ? -__expf(A.in[11][lane & 7]) : 0.f, hp_b = A.in[12][lane & 7];
    for (int m = gw; m < MP; m += NGW) {
        GAS unsigned long long* o8 = (GAS unsigned long long*)(WSB(bf16, WS_H) + (size_t)m * DM) + lane;
        if (m >= NTOK) {
#pragma unroll
            for (int j = 0; j < 4; ++j) o8[64 * j] = 0ull;
            continue; }
        const float* xrow = m < ROW0 ? A.in[6] + (size_t)m * DM : (m < NPR ? A.in[0] + (size_t)(m - ROW0) * DM : A.in[1] + (size_t)(m - NPR) * DM);
        const GAS f32x4* xr = (const GAS f32x4*)xrow + lane;
        f32x4 v[4]; float s = 0.f;
#pragma unroll
        for (int j = 0; j < 4; ++j) { v[j] = xr[64 * j]; s += (v[j].x + v[j].y) + (v[j].z + v[j].w); }
        const float mean = wave_sum(s) * (1.f / DM); float s2 = 0.f;
#pragma unroll
        for (int j = 0; j < 4; ++j) { v[j] = v[j] - mean; s2 += (v[j].x * v[j].x + v[j].y * v[j].y) + (v[j].z * v[j].z + v[j].w * v[j].w); }
        const float rstd = 1.f / sqrtf(wave_sum(s2) * (1.f / DM) + LN_EPS);
#pragma unroll
        for (int j = 0; j < 4; ++j) { v[j] = v[j] * rstd * lg[j] + lb[j];
            o8[64 * j] = (unsigned long long)pk2(v[j].x, v[j].y) | ((unsigned long long)pk2(v[j].z, v[j].w) << 32); }
        float ab = 0.f;
#pragma unroll
        for (int e = 0; e < 16; ++e) { float p = 0.f;
#pragma unroll
            for (int j = 0; j < 4; ++j) { const f32x4 w = *(const LAS f32x4*)(wab + e * 1024 + 256 * j + 4 * lane); p += (v[j].x * w.x + v[j].y * w.y) + (v[j].z * w.z + v[j].w * w.w); }
            p = wave_sum(p); if (lane == e) ab = p; }
        if (lane < 16) {
            float r;
            if (lane < 8) { const float xx = ab + hp_b; const float sp = fmaxf(xx, 0.f) + log1pf(__expf(-fabsf(xx))); r = hp_a * sp; }
            else r = 1.f / (1.f + __expf(-ab));
            OBB(float, OB_GB)[(size_t)m * 16 + lane] = r; }
    }
}

constexpr int L_QH = 0, L_KH = 9216, L_VH = 18432, L_KDT = 27648, L_QKB = 36864, L_WUT = 46080, L_AF = 64512, L_GS = 80896, L_BS = 81152, L_R = 81408;
constexpr int L_KS = 0, L_VT = 27648, L_BREL = 118784;

__device__ __forceinline__ void load8(float (&x)[8], const Args& A, int chunk, int slot, int colb) {
    if (chunk < NCHP) {
        const int row = 64 * chunk + slot - 48;
        if (row >= 0) { unpack8(*(const GAS v4u*)(WSB(bf16, WS_PROJ) + (size_t)row * NPROJ + colb), x); return; }
    } else {
        const int b = chunk - NCHP, ti = slot - 32;
        if (ti >= 0) { unpack8(*(const GAS v4u*)(WSB(bf16, WS_PROJ) + (size_t)(NPR + 32 * b + ti) * NPROJ + colb), x); return; }
        if (ti >= -3) { const GAS f32x4* p = (const GAS f32x4*)(A.in[3] + ((size_t)b * 3 + (3 + ti)) * 1536 + colb); const f32x4 a = p[0], c = p[1];
            x[0] = a.x; x[1] = a.y; x[2] = a.z; x[3] = a.w; x[4] = c.x; x[5] = c.y; x[6] = c.z; x[7] = c.w; return; }
    }
#pragma unroll
    for (int e = 0; e < 8; ++e) x[e] = 0.f;
}

__device__ __forceinline__ void prep_item(const Frame& F, const Args& A, int chunk, int h) {
    LAS bf16* qh = (LAS bf16*)(F.lds + L_QH); LAS bf16* kh = (LAS bf16*)(F.lds + L_KH); LAS bf16* vh = (LAS bf16*)(F.lds + L_VH);
    LAS bf16* kdT = (LAS bf16*)(F.lds + L_KDT); LAS bf16* qkb = (LAS bf16*)(F.lds + L_QKB); LAS bf16* WUT = (LAS bf16*)(F.lds + L_WUT);
    LAS float* Af = (LAS float*)(F.lds + L_AF); LAS float* Gs = (LAS float*)(F.lds + L_GS); LAS float* Bs = (LAS float*)(F.lds + L_BS);
    const int t = F.tid, lane = F.lane, fr = F.fr, fq = F.fq, item = chunk * 8 + h;
    if (t < 384) {
        const int which = t >> 7, rem = t & 127, tr = rem >> 3, dg = rem & 7, i0 = tr * 4, colb = which * 512 + h * 64 + dg * 8;
        float x[7][8], w[4][8];
#pragma unroll
        for (int n = 0; n < 7; ++n) load8(x[n], A, chunk, i0 - 3 + n, colb);
#pragma unroll
        for (int j = 0; j < 4; ++j) { const GAS f32x4* p = (const GAS f32x4*)(A.in[10] + (size_t)j * 1536 + colb); const f32x4 a = p[0], c = p[1];
            w[j][0] = a.x; w[j][1] = a.y; w[j][2] = a.z; w[j][3] = a.w; w[j][4] = c.x; w[j][5] = c.y; w[j][6] = c.z; w[j][7] = c.w; }
        LAS bf16* dst = which == 0 ? qh : (which == 1 ? kh : vh);
#pragma unroll
        for (int no = 0; no < 4; ++no) {
            const int slot = i0 + no; const bool valid = slot_row(chunk, slot) >= 0;
            float y[8]; float ss = 0.f;
#pragma unroll
            for (int e = 0; e < 8; ++e) { float a = x[no][e] * w[0][e] + x[no + 1][e] * w[1][e] + x[no + 2][e] * w[2][e] + x[no + 3][e] * w[3][e];
                a = a / (1.f + __expf(-a)); a = valid ? a : 0.f; y[e] = a; ss += a * a; }
            ss += __shfl_xor(ss, 1); ss += __shfl_xor(ss, 2); ss += __shfl_xor(ss, 4);
            const float sc = which == 2 ? 1.f : (rsqrtf(ss + NORM_EPS) * (which == 0 ? 0.125f : 1.f));
            v4u o; o.x = pk2(y[0] * sc, y[1] * sc); o.y = pk2(y[2] * sc, y[3] * sc); o.z = pk2(y[4] * sc, y[5] * sc); o.w = pk2(y[6] * sc, y[7] * sc);
            *(LAS v4u*)(dst + slot * 72 + dg * 8) = o;
        }
    } else if (t < 448) {
        const int i = t - 384, row = slot_row(chunk, i);
        Gs[i] = row >= 0 ? OBB(float, OB_GB)[(size_t)row * 16 + h] : 0.f; Bs[i] = row >= 0 ? OBB(float, OB_GB)[(size_t)row * 16 + 8 + h] : 0.f;
    }
    __syncthreads();
    if (F.wave == 0) { float x = Gs[lane];
#pragma unroll
        for (int d = 1; d < 64; d <<= 1) { const float y = __shfl_up(x, d); if (lane >= d) x += y; }
        Gs[lane] = x; }
    __syncthreads();
    {
        const int p = F.wave >> 2, mt = F.wave & 3; LAS const bf16* src = p ? qh : kh;
        const bf16x8 a0 = *(LAS const bf16x8*)(src + (16 * mt + fr) * 72 + 8 * fq), a1 = *(LAS const bf16x8*)(src + (16 * mt + fr) * 72 + 32 + 8 * fq);
#pragma unroll
        for (int nt = 0; nt < 4; ++nt) {
            const int j = 16 * nt + fr;
            if (nt <= mt) {
                const bf16x8 b0 = *(LAS const bf16x8*)(kh + j * 72 + 8 * fq), b1 = *(LAS const bf16x8*)(kh + j * 72 + 32 + 8 * fq);
                f32x4 acc = {0.f, 0.f, 0.f, 0.f}; acc = mfma16(a0, b0, acc); acc = mfma16(a1, b1, acc);
                const float gj = Gs[j];
#pragma unroll
                for (int r = 0; r < 4; ++r) { const int i = 16 * mt + 4 * fq + r; const float dec = __expf(fminf(Gs[i] - gj, 0.f));
                    if (p == 0) Af[i * 64 + j] = (i > j) ? Bs[i] * acc[r] * dec : 0.f;
                    else qkb[i * 72 + j] = f2bf((i >= j) ? acc[r] * dec : 0.f); }
            } else if (p == 1) {
#pragma unroll
                for (int r = 0; r < 4; ++r) qkb[(16 * mt + 4 * fq + r) * 72 + j] = 0;
            }
        }
        const int c = t & 63, dg = t >> 6; const float f = __expf(Gs[63] - Gs[c]); float kv[8];
        unpack8(*(LAS const v4u*)(kh + c * 72 + 8 * dg), kv);
#pragma unroll
        for (int e = 0; e < 8; ++e) kdT[(8 * dg + e) * 72 + c] = f2bf(kv[e] * f);
        LAS float* Rs = (LAS float*)(F.lds + L_R);
#pragma unroll
        for (int rep = 0; rep < 2; ++rep) { const int i = (t >> 4) + 32 * rep, c8 = t & 15; const bool isw = c8 < 8; float rv[8];
            unpack8(*(LAS const v4u*)((isw ? kh : vh) + i * 72 + 8 * (c8 & 7)), rv); const float f2 = Bs[i] * (isw ? __expf(Gs[i]) : 1.f);
            const f32x4 r0 = {rv[0] * f2, rv[1] * f2, rv[2] * f2, rv[3] * f2}, r1 = {rv[4] * f2, rv[5] * f2, rv[6] * f2, rv[7] * f2};
            *(LAS f32x4*)(Rs + i * 128 + 8 * c8) = r0; *(LAS f32x4*)(Rs + i * 128 + 8 * c8 + 4) = r1; }
    }
    __syncthreads();
#ifndef NO_SOLVE
    if (F.wave < 2) {
        float x[64];
#pragma unroll
        for (int i = 0; i < 64; ++i) x[i] = 0.f;
        LAS const float* Ao = Af; LAS const float* Ro = (LAS const float*)(F.lds + L_R) + t;
        asm volatile("" : "+v"(Ao), "+v"(Ro));
#pragma unroll
        for (int i = 0; i < 64; ++i) {
            float s = Ro[i * 128];
#pragma unroll
            for (int j4 = 0; j4 < (i + 3) / 4; ++j4) { const f32x4 a = *(LAS const f32x4*)(Ao + i * 64 + 4 * j4);
                s -= a.x * x[4 * j4]; s -= a.y * x[4 * j4 + 1]; s -= a.z * x[4 * j4 + 2]; s -= a.w * x[4 * j4 + 3]; }
            x[i] = s;
        }
#pragma unroll
        for (int c8 = 0; c8 < 8; ++c8) { v4u o; o.x = pk2(x[8 * c8], x[8 * c8 + 1]); o.y = pk2(x[8 * c8 + 2], x[8 * c8 + 3]); o.z = pk2(x[8 * c8 + 4], x[8 * c8 + 5]); o.w = pk2(x[8 * c8 + 6], x[8 * c8 + 7]);
            *(LAS v4u*)(WUT + t * 72 + 8 * c8) = o; }
    }
#endif
    __syncthreads();
    {
        const int w4 = F.wave & 3; const bool second = F.wave >= 4;
        {
            LAS const bf16* bsrc = second ? qkb : kdT;
            const bf16x8 b0 = *(LAS const bf16x8*)(bsrc + (16 * w4 + fr) * 72 + 8 * fq), b1 = *(LAS const bf16x8*)(bsrc + (16 * w4 + fr) * 72 + 32 + 8 * fq);
            f32x4 cp[4];
#pragma unroll
            for (int mt = 0; mt < 4; ++mt) { const bf16x8 a0 = *(LAS const bf16x8*)(WUT + (16 * mt + fr) * 72 + 8 * fq), a1 = *(LAS const bf16x8*)(WUT + (16 * mt + fr) * 72 + 32 + 8 * fq);
                f32x4 acc = {0.f, 0.f, 0.f, 0.f}; acc = mfma16(a0, b0, acc); acc = mfma16(a1, b1, acc); cp[mt] = acc; }
            if (!second) {
#pragma unroll
                for (int mt = 0; mt < 4; ++mt) cp[mt] = -cp[mt];
            } else {
                const int i = 16 * w4 + fr; const float eg = __expf(Gs[i]);
#pragma unroll
                for (int mt = 0; mt < 4; ++mt) { const v2u qq = *(LAS const v2u*)(qh + i * 72 + 16 * mt + 4 * fq);
                    cp[mt][0] = bf2f(qq.x & 0xffffu) * eg - cp[mt][0]; cp[mt][1] = bf2f(qq.x >> 16) * eg - cp[mt][1]; cp[mt][2] = bf2f(qq.y & 0xffffu) * eg - cp[mt][2]; cp[mt][3] = bf2f(qq.y >> 16) * eg - cp[mt][3]; }
            }
            bf16* dstg = (second ? WSB(bf16, WS_PREP + PREP_ARR) : WSB(bf16, WS_PREP)) + (size_t)item * 4096;
            *(GAS bf16x8*)(dstg + ((w4 * 2 + 0) * 64 + lane) * 8) = pack8(cp[0], cp[1]);
            *(GAS bf16x8*)(dstg + ((w4 * 2 + 1) * 64 + lane) * 8) = pack8(cp[2], cp[3]);
        }
        {
            LAS const bf16* asrc = second ? qkb : kdT;
            const bf16x8 a0 = *(LAS const bf16x8*)(asrc + (16 * w4 + fr) * 72 + 8 * fq), a1 = *(LAS const bf16x8*)(asrc + (16 * w4 + fr) * 72 + 32 + 8 * fq);
            bf16* dstg = (second ? WSB(bf16, WS_PREP + 3 * PREP_ARR) : WSB(bf16, WS_PREP + 2 * PREP_ARR)) + (size_t)item * 4096;
#pragma unroll
            for (int nt = 0; nt < 4; ++nt) { const bf16x8 b0 = *(LAS const bf16x8*)(WUT + (64 + 16 * nt + fr) * 72 + 8 * fq), b1 = *(LAS const bf16x8*)(WUT + (64 + 16 * nt + fr) * 72 + 32 + 8 * fq);
                f32x4 acc = {0.f, 0.f, 0.f, 0.f}; acc = mfma16(a0, b0, acc); acc = mfma16(a1, b1, acc);
                v2u o; o.x = pk2(acc[0], acc[1]); o.y = pk2(acc[2], acc[3]);
                *(GAS v2u*)(dstg + ((nt * 4 + w4) * 64 + lane) * 4) = o; }
        }
        if (t == 0) WSB(float, WS_GT)[item] = __expf(Gs[63]);
    }
    __syncthreads();
}

__device__ __forceinline__ void swa_item(const Frame& F, const Args& A, int chunk, int kvh) {
    LAS bf16* Ks = (LAS bf16*)(F.lds + L_KS); LAS bf16* VT = (LAS bf16*)(F.lds + L_VT); LAS const float* brel = (LAS const float*)(F.lds + L_BREL);
    const int t = F.tid, lane = F.lane, fr = F.fr, fq = F.fq;
#pragma nounroll
    for (int idx = t; idx < 1536; idx += NTHR) {
        const int key = idx >> 3, dg = idx & 7; float kx[8], vx[8]; bool have = false;
        if (chunk < NCHP) { const int row = 64 * chunk + key - 128 - 48;
            if (row >= 0) { unpack8(*(const GAS v4u*)(WSB(bf16, WS_PROJ) + (size_t)row * NPROJ + C_SK + kvh * 64 + 8 * dg), kx); unpack8(*(const GAS v4u*)(WSB(bf16, WS_PROJ) + (size_t)row * NPROJ + C_SV + kvh * 64 + 8 * dg), vx); have = true; }
        } else { const int b = chunk - NCHP;
            if (key >= 160) { const int row = NPR + 32 * b + (key - 160);
                unpack8(*(const GAS v4u*)(WSB(bf16, WS_PROJ) + (size_t)row * NPROJ + C_SK + kvh * 64 + 8 * dg), kx); unpack8(*(const GAS v4u*)(WSB(bf16, WS_PROJ) + (size_t)row * NPROJ + C_SV + kvh * 64 + 8 * dg), vx); have = true; }
            else if (key >= 32) { const size_t off = (((size_t)b * 128 + (key - 32)) * 2 + kvh) * 64 + 8 * dg;
                const GAS f32x4* pk = (const GAS f32x4*)(A.in[4] + off); const GAS f32x4* pv = (const GAS f32x4*)(A.in[5] + off); const f32x4 a = pk[0], c = pk[1], d = pv[0], e = pv[1];
                kx[0] = a.x; kx[1] = a.y; kx[2] = a.z; kx[3] = a.w; kx[4] = c.x; kx[5] = c.y; kx[6] = c.z; kx[7] = c.w;
                vx[0] = d.x; vx[1] = d.y; vx[2] = d.z; vx[3] = d.w; vx[4] = e.x; vx[5] = e.y; vx[6] = e.z; vx[7] = e.w; have = true; }
        }
        if (!have) {
#pragma unroll
            for (int e = 0; e < 8; ++e) { kx[e] = 0.f; vx[e] = 0.f; } }
        v4u o; o.x = pk2(kx[0], kx[1]); o.y = pk2(kx[2], kx[3]); o.z = pk2(kx[4], kx[5]); o.w = pk2(kx[6], kx[7]);
        *(LAS v4u*)(Ks + key * 72 + 8 * dg) = o;
#pragma unroll
        for (int e = 0; e < 8; ++e) VT[(8 * dg + e) * 200 + key] = f2bf(vx[e]);
    }
    __syncthreads();
    const int hq = kvh * 4 + (F.wave >> 1), qt0 = (F.wave & 1) * 2;
    const int kv0 = chunk < NCHP ? (176 - 64 * chunk > 0 ? 176 - 64 * chunk : 0) : 32;
    const float sink = A.in[14][hq];
#pragma nounroll
    for (int qi = 0; qi < 2; ++qi) {
        f32x4 sc[12];
        LAS const bf16* kp = Ks + fr * 72 + 8 * fq; LAS const bf16* vp = VT + fr * 200 + 4 * fq;
        const int qs = 16 * (qt0 + qi) + fr;
        LAS const float* bp = brel + hq * 256 + 63 + 4 * fq - qs;
        asm volatile("" : "+v"(kp), "+v"(vp), "+v"(bp));
        {
            const int row = slot_row(chunk, qs);
            bf16x8 bq0 = {0, 0, 0, 0, 0, 0, 0, 0}, bq1 = {0, 0, 0, 0, 0, 0, 0, 0};
            if (row >= 0) { const GAS bf16x8* qp = (const GAS bf16x8*)(WSB(bf16, WS_PROJ) + (size_t)row * NPROJ + C_SQ + hq * 64 + 8 * fq); bq0 = qp[0]; bq1 = qp[4]; }
#pragma unroll
            for (int kt = 0; kt < 12; ++kt) { const bf16x8 a0 = *(LAS const bf16x8*)(kp + kt * 16 * 72), a1 = *(LAS const bf16x8*)(kp + kt * 16 * 72 + 32);
                f32x4 acc = {0.f, 0.f, 0.f, 0.f}; acc = mfma16(a0, bq0, acc); acc = mfma16(a1, bq1, acc); sc[kt] = acc; }
            float mx = sink;
#pragma unroll
            for (int kt = 0; kt < 12; ++kt)
#pragma unroll
                for (int r = 0; r < 4; ++r) { const int key = 16 * kt + 4 * fq + r; float s = sc[kt][r] * 0.125f + bp[16 * kt + r];
                    s = key < kv0 ? -INFINITY : s; sc[kt][r] = s; mx = fmaxf(mx, s); }
            mx = fmaxf(mx, __shfl_xor(mx, 16)); mx = fmaxf(mx, __shfl_xor(mx, 32));
            float sum = 0.f;
#pragma unroll
            for (int kt = 0; kt < 12; ++kt)
#pragma unroll
                for (int r = 0; r < 4; ++r) { const float p = __expf(sc[kt][r] - mx); sc[kt][r] = p; sum += p; }
            sum += __shfl_xor(sum, 16); sum += __shfl_xor(sum, 32);
            const float inv = 1.f / (sum + __expf(sink - mx));
#pragma unroll
            for (int kt = 0; kt < 12; ++kt) sc[kt] = sc[kt] * inv;
        }
        f32x4 o[4];
#pragma unroll
        for (int dt = 0; dt < 4; ++dt) o[dt] = (f32x4){0.f, 0.f, 0.f, 0.f};
#pragma unroll
        for (int ks = 0; ks < 6; ++ks) {
            const bf16x8 pa = pack8(sc[2 * ks], sc[2 * ks + 1]);
#pragma unroll
            for (int dt = 0; dt < 4; ++dt) { const v2u lo = *(LAS const v2u*)(vp + dt * 16 * 200 + 32 * ks), hi = *(LAS const v2u*)(vp + dt * 16 * 200 + 32 * ks + 16);
                v4u w; w.x = lo.x; w.y = lo.y; w.z = hi.x; w.w = hi.y; o[dt] = mfma16(pa, __builtin_bit_cast(bf16x8, w), o[dt]); }
        }
#pragma unroll
        for (int r = 0; r < 4; ++r) { const int row = slot_row(chunk, 16 * (qt0 + qi) + 4 * fq + r);
            if (row >= 0) {
#pragma unroll
                for (int dt = 0; dt < 4; ++dt) OBB(bf16, OB_MIX)[(size_t)row * DM + 512 + hq * 64 + 16 * dt + fr] = f2bf(o[dt][r]); } }
    }
    __syncthreads();
}

__device__ __forceinline__ void p2_phase(const Frame& F, const Args& A) {
    {
        const size_t gt = (size_t)F.bid * NTHR + F.tid, GS = (size_t)F.G * NTHR;
        constexpr size_t n0 = 4608, n1 = n0 + 16384, n2 = n1 + 16384, n3 = n2 + 147456, n4 = n3 + 131072, n5 = n4 + 131072;
        for (size_t i = gt; i < n5; i += GS) {
            size_t oo; size_t row; int col;
            if (i < n0) { row = NPR - 3 + i / 1536; col = (int)(i % 1536); oo = O_PSC + i; }
            else if (i < n1) { const size_t k = i - n0; row = NPR - 128 + k / 128; col = C_SK + (int)(k % 128); oo = O_PK + k; }
            else if (i < n2) { const size_t k = i - n1; row = NPR - 128 + k / 128; col = C_SV + (int)(k % 128); oo = O_PV + k; }
            else if (i < n3) { const size_t k = i - n2; const size_t b = k / 4608, rr = (k % 4608) / 1536; row = NPR + 32 * b + 29 + rr; col = (int)(k % 1536); oo = O_SSC + k; }
            else if (i < n4) { const size_t k = i - n3; row = NPR + k / 128; col = C_SK + (int)(k % 128); oo = O_SK + k; }
            else { const size_t k = i - n4; row = NPR + k / 128; col = C_SV + (int)(k % 128); oo = O_SV + k; }
            A.out[oo] = bf2f(WSB(bf16, WS_PROJ)[row * NPROJ + col]);
        }
    }
    for (int it = F.bid; it < NITEM; it += F.G) prep_item(F, A, it >> 3, it & 7);
}

__device__ __forceinline__ void scan_job(const Frame& F, const Args& A, int h, int chunk0, int nsteps, const float* S0, float* Sout) {
    const int nt = F.wave, lane = F.lane, fr = F.fr, fq = F.fq;
    f32x4 S[4];
#pragma unroll
    for (int mt = 0; mt < 4; ++mt)
#pragma unroll
        for (int r = 0; r < 4; ++r) S[mt][r] = S0 ? S0[(16 * mt + 4 * fq + r) * 64 + 16 * nt + fr] : 0.f;
    size_t item = (size_t)chunk0 * 8 + h;
    bf16x8 q[4][2]; v2u nb[4]; float gt;
#pragma unroll
    for (int mt = 0; mt < 4; ++mt) { q[mt][0] = *(const GAS bf16x8*)(WSB(bf16, WS_PREP) + item * 4096 + ((mt * 2 + 0) * 64 + lane) * 8); q[mt][1] = *(const GAS bf16x8*)(WSB(bf16, WS_PREP) + item * 4096 + ((mt * 2 + 1) * 64 + lane) * 8);
        nb[mt] = *(const GAS v2u*)(WSB(bf16, WS_PREP + 2 * PREP_ARR) + item * 4096 + ((nt * 4 + mt) * 64 + lane) * 4); }
    gt = WSB(float, WS_GT)[item];
    for (int c = 0; c < nsteps; ++c) {
        const size_t nitem = item + (c + 1 < nsteps ? 8 : 0);
        bf16x8 q2[4][2]; v2u nb2[4];
#pragma unroll
        for (int mt = 0; mt < 4; ++mt) { q2[mt][0] = *(const GAS bf16x8*)(WSB(bf16, WS_PREP) + nitem * 4096 + ((mt * 2 + 0) * 64 + lane) * 8); q2[mt][1] = *(const GAS bf16x8*)(WSB(bf16, WS_PREP) + nitem * 4096 + ((mt * 2 + 1) * 64 + lane) * 8);
            nb2[mt] = *(const GAS v2u*)(WSB(bf16, WS_PREP + 2 * PREP_ARR) + nitem * 4096 + ((nt * 4 + mt) * 64 + lane) * 4); }
        const float gt2 = WSB(float, WS_GT)[nitem];
        const bf16x8 sb0 = pack8(S[0], S[1]), sb1 = pack8(S[2], S[3]);
        *(GAS bf16x8*)(OBB(bf16, OB_SC) + item * 4096 + ((nt * 2 + 0) * 64 + lane) * 8) = sb0;
        *(GAS bf16x8*)(OBB(bf16, OB_SC) + item * 4096 + ((nt * 2 + 1) * 64 + lane) * 8) = sb1;
#pragma unroll
        for (int mt = 0; mt < 4; ++mt) {
            f32x4 acc; acc[0] = S[mt][0] * gt + bf2f(nb[mt].x & 0xffffu); acc[1] = S[mt][1] * gt + bf2f(nb[mt].x >> 16); acc[2] = S[mt][2] * gt + bf2f(nb[mt].y & 0xffffu); acc[3] = S[mt][3] * gt + bf2f(nb[mt].y >> 16);
            acc = mfma16(q[mt][0], sb0, acc); acc = mfma16(q[mt][1], sb1, acc); S[mt] = acc; }
#pragma unroll
        for (int mt = 0; mt < 4; ++mt) { q[mt][0] = q2[mt][0]; q[mt][1] = q2[mt][1]; nb[mt] = nb2[mt]; }
        gt = gt2; item = nitem;
    }
#pragma unroll
    for (int mt = 0; mt < 4; ++mt)
#pragma unroll
        for (int r = 0; r < 4; ++r) Sout[(16 * mt + 4 * fq + r) * 64 + 16 * nt + fr] = S[mt][r];
}
constexpr int SR_SLOT = 10240, SR_GT = 12 * SR_SLOT;
__device__ __forceinline__ void scan_ring(const Frame& F, const Args& A, int h, int nt) {
    const int lane = F.lane, fr = F.fr, fq = F.fq, w = F.wave;
    LAS float* gts = (LAS float*)(F.lds + SR_GT);
    for (int t = F.tid; t < NCHP; t += NTHR) gts[t] = WSB(float, WS_GT)[t * 8 + h];
    const bf16* QFh = WSB(bf16, WS_PREP) + (size_t)h * 4096; const bf16* NBh = WSB(bf16, WS_PREP + 2 * PREP_ARR) + (size_t)h * 4096 + nt * 1024;
    constexpr int NG = (NCHP + 3) / 4;
#define SR_ISSUE(g) do { if (w > 0) { _Pragma("unroll") for (int k = 0; k < 6; ++k) { int L = (w - 1) + 7 * k; if (L >= 40) L -= 40; const int st = L / 10, pc = L % 10; \
        int c = 4 * (g) + st; c = c < NCHP ? c : NCHP - 1; \
        const bf16* src = (pc < 8 ? QFh + (size_t)c * 8 * 4096 + pc * 512 : NBh + (size_t)c * 8 * 4096 + (pc - 8) * 512) + lane * 8; \
        __builtin_amdgcn_global_load_lds((const unsigned*)src, (LAS unsigned*)(F.lds + ((((g) % 3) * 4 + st) * SR_SLOT + pc * 1024)), 16, 0, 0); } } } while (0)
    SR_ISSUE(0); SR_ISSUE(1);
    asm volatile("s_waitcnt vmcnt(0) lgkmcnt(0)" ::: "memory"); __builtin_amdgcn_s_barrier(); asm volatile("" ::: "memory");
    f32x4 S[4];
#pragma unroll
    for (int mt = 0; mt < 4; ++mt) S[mt] = (f32x4){0.f, 0.f, 0.f, 0.f};
    bf16* SCh = OBB(bf16, OB_SC) + (size_t)h * 4096 + nt * 1024;
    for (int g = 0; g < NG; ++g) {
        SR_ISSUE(g + 2);
        if (w == 0) {
#pragma unroll
            for (int st = 0; st < 4; ++st) {
                const int c = 4 * g + st;
                if (c < NCHP) {
                    LAS const unsigned char* slot = F.lds + ((g % 3) * 4 + st) * SR_SLOT;
                    const float gt = gts[c];
                    const bf16x8 sb0 = pack8(S[0], S[1]), sb1 = pack8(S[2], S[3]);
                    *(GAS bf16x8*)(SCh + (size_t)c * 8 * 4096 + lane * 8) = sb0;
                    *(GAS bf16x8*)(SCh + (size_t)c * 8 * 4096 + 512 + lane * 8) = sb1;
#pragma unroll
                    for (int mt = 0; mt < 4; ++mt) {
                        const bf16x8 q0 = *(LAS const bf16x8*)(slot + (mt * 2 + 0) * 1024 + lane * 16), q1 = *(LAS const bf16x8*)(slot + (mt * 2 + 1) * 1024 + lane * 16);
                        const v2u nb = *(LAS const v2u*)(slot + 8192 + mt * 512 + lane * 8);
                        f32x4 acc; acc[0] = S[mt][0] * gt + bf2f(nb.x & 0xffffu); acc[1] = S[mt][1] * gt + bf2f(nb.x >> 16); acc[2] = S[mt][2] * gt + bf2f(nb.y & 0xffffu); acc[3] = S[mt][3] * gt + bf2f(nb.y >> 16);
                        acc = mfma16(q0, sb0, acc); acc = mfma16(q1, sb1, acc); S[mt] = acc; }
                }
            }
            asm volatile("s_waitcnt lgkmcnt(0)" ::: "memory");
        } else {
            asm volatile("s_waitcnt vmcnt(6)" ::: "memory");
        }
        __builtin_amdgcn_s_barrier(); asm volatile("" ::: "memory");
    }
#undef SR_ISSUE
    asm volatile("s_waitcnt vmcnt(0)" ::: "memory");
    if (w == 0) { float* Sout = A.out + O_PSD + (size_t)h * 4096;
#pragma unroll
        for (int mt = 0; mt < 4; ++mt)
#pragma unroll
            for (int r = 0; r < 4; ++r) Sout[(16 * mt + 4 * fq + r) * 64 + 16 * nt + fr] = S[mt][r]; }
    __syncthreads();
}
__device__ __forceinline__ void p3_phase(const Frame& F, const Args& A) {
    if (F.bid < 32) { scan_ring(F, A, F.bid & 7, F.bid >> 3); return; }
    if (F.wave < 4) for (int j = F.bid - 32; j < 256; j += F.G - 32) { const int b = j >> 3, h = j & 7; scan_job(F, A, h, NCHP + b, 1, A.in[2] + (size_t)j * 4096, A.out + O_SSD + (size_t)j * 4096); }
    LAS float* brel = (LAS float*)(F.lds + L_BREL);
    for (int idx = F.tid; idx < 8 * 256; idx += NTHR) { const int hq = idx >> 8, rel = (idx & 255) - 191, n = rel < 0 ? -rel : rel;
        int bkt; if (n < 8) bkt = n; else { const int large = 8 + (31 - __clz(n * n)) - 6; bkt = large < 15 ? large : 15; }
        if (rel > 0) bkt += 16;
        brel[idx] = (idx & 255) < 255 ? A.in[15][bkt * 8 + hq] : 0.f; }
    __syncthreads();
    for (int k = F.bid - 32; k < NCH * 2; k += F.G - 32) swa_item(F, A, k >> 1, k & 1);
}

__device__ __forceinline__ void p4_phase(const Frame& F, const Args& A) {
    const int gw = F.bid * NWAVES + F.wave, NGW = F.G * NWAVES, lane = F.lane, fr = F.fr, fq = F.fq;
    for (int u = gw; u < NITEM * 4; u += NGW) {
        const size_t item = u >> 2; const int mt = u & 3, chunk = (int)(item >> 3), h = (int)(item & 7);
        const bf16x8 p0 = *(const GAS bf16x8*)(WSB(bf16, WS_PREP + PREP_ARR) + item * 4096 + ((mt * 2 + 0) * 64 + lane) * 8), p1 = *(const GAS bf16x8*)(WSB(bf16, WS_PREP + PREP_ARR) + item * 4096 + ((mt * 2 + 1) * 64 + lane) * 8);
        f32x4 o[4]; float ss[4] = {0.f, 0.f, 0.f, 0.f};
#pragma unroll
        for (int nt = 0; nt < 4; ++nt) {
            const bf16x8 s0 = *(const GAS bf16x8*)(OBB(bf16, OB_SC) + item * 4096 + ((nt * 2 + 0) * 64 + lane) * 8), s1 = *(const GAS bf16x8*)(OBB(bf16, OB_SC) + item * 4096 + ((nt * 2 + 1) * 64 + lane) * 8);
            const v2u om = *(const GAS v2u*)(WSB(bf16, WS_PREP + 3 * PREP_ARR) + item * 4096 + ((nt * 4 + mt) * 64 + lane) * 4);
            f32x4 acc; acc[0] = bf2f(om.x & 0xffffu); acc[1] = bf2f(om.x >> 16); acc[2] = bf2f(om.y & 0xffffu); acc[3] = bf2f(om.y >> 16);
            acc = mfma16(p0, s0, acc); acc = mfma16(p1, s1, acc); o[nt] = acc;
#pragma unroll
            for (int r = 0; r < 4; ++r) ss[r] += acc[r] * acc[r];
        }
#pragma unroll
        for (int r = 0; r < 4; ++r) { float s = ss[r]; s += __shfl_xor(s, 1); s += __shfl_xor(s, 2); s += __shfl_xor(s, 4); s += __shfl_xor(s, 8); ss[r] = rsqrtf(s * (1.f / 64.f) + NORM_EPS); }
#pragma unroll
        for (int r = 0; r < 4; ++r) { const int row = slot_row(chunk, 16 * mt + 4 * fq + r);
            if (row >= 0) {
#pragma unroll
                for (int nt = 0; nt < 4; ++nt) { const int v = 16 * nt + fr; const float z = bf2f(WSB(bf16, WS_PROJ)[(size_t)row * NPROJ + C_Z + h * 64 + v]);
                    OBB(bf16, OB_MIX)[(size_t)row * DM + h * 64 + v] = f2bf(o[nt][r] * ss[r] * A.in[13][v] * (z / (1.f + __expf(-z)))); } } }
    }
}

__device__ __forceinline__ void ln_rows(const Frame& F, const float* src, const float* g, const float* b, bf16* dstb, float* dstf) {
    const int gw = F.bid * NWAVES + F.wave, NGW = F.G * NWAVES, lane = F.lane;
    f32x4 lg[4], lb[4];
#pragma unroll
    for (int j = 0; j < 4; ++j) { lg[j] = ((const GAS f32x4*)g)[64 * j + lane]; lb[j] = ((const GAS f32x4*)b)[64 * j + lane]; }
    for (int m = gw; m < M2; m += NGW) {
        const GAS f32x4* xr = (const GAS f32x4*)(src + (size_t)m * DM) + lane;
        f32x4 v[4]; float s = 0.f;
#pragma unroll
        for (int j = 0; j < 4; ++j) { v[j] = xr[64 * j]; s += (v[j].x + v[j].y) + (v[j].z + v[j].w); }
        const float mean = wave_sum(s) * (1.f / DM); float s2 = 0.f;
#pragma unroll
        for (int j = 0; j < 4; ++j) { v[j] = v[j] - mean; s2 += (v[j].x * v[j].x + v[j].y * v[j].y) + (v[j].z * v[j].z + v[j].w * v[j].w); }
        const float rstd = 1.f / sqrtf(wave_sum(s2) * (1.f / DM) + LN_EPS);
#pragma unroll
        for (int j = 0; j < 4; ++j) { v[j] = v[j] * rstd * lg[j] + lb[j];
            if (dstb) ((GAS unsigned long long*)(dstb + (size_t)m * DM) + lane)[64 * j] = (unsigned long long)pk2(v[j].x, v[j].y) | ((unsigned long long)pk2(v[j].z, v[j].w) << 32);
            else ((GAS f32x4*)(dstf + (size_t)m * DM) + lane)[64 * j] = v[j]; }
    }
}

__global__ void __launch_bounds__(NTHR, 2) mk_fwd(Args args) {
    extern __shared__ __attribute__((aligned(16))) unsigned char lds[];
    Frame F;
    F.lds = (LAS unsigned char*)lds;
    F.tid = threadIdx.x; F.lane = F.tid & 63; F.wave = __builtin_amdgcn_readfirstlane(F.tid >> 6); F.fr = F.lane & 15; F.fq = F.lane >> 4;
    F.G = gridDim.x; F.bid = blockIdx.x;
    const Args& A = args; unsigned char* ws = args.ws;
    for (int u = F.tid; u < (LDS_BYTES - LDSCTL_OFF) / 4; u += NTHR) ((LAS unsigned*)(F.lds + LDSCTL_OFF))[u] = 0u;
    __syncthreads();
    XcdBarrier bar; bar.bar = (unsigned*)(ws + WS_CTL) + CW_BAR + args.li * XCD_BAR_WORDS; bar.x = 0; bar.st = nullptr;
    if (N_LAUNCHES == 1) bar = xcd_barrier_post((unsigned*)(ws + WS_CTL) + CW_BAR + args.li * XCD_BAR_WORDS, (volatile LAS unsigned*)(F.lds + MISC_OFF) + 8);
    const int lo = args.ph_lo, hi = args.ph_hi;
#ifndef PHASE_MASK
#define PHASE_MASK 0x3ff
#endif
#define IN(k) (((PHASE_MASK >> (k)) & 1) && lo <= (k) && (k) < hi)
#define SEAM(k) do { if (IN(k) && IN((k) + 1)) xcd_barrier(bar); } while (0)

    if (IN(0)) { p0_prologue(F, A); } SEAM(0);
    if (IN(1)) {
        pg8::Gemm g{WSB(bf16, WS_H), WSB(bf16, WS_WIN), MP, NPROJ, DM}; pg8::StaticOrder S; S.init(MP, NPROJ, F.G, F.bid);
        pg8::EpiBf16<0> E{WSB(bf16, WS_PROJ), NPROJ};
        pg8::gemm_phase<pg8::EpiBf16<0>, pg8::StaticOrder, true, true>(F.lds, g, S, E);
    } SEAM(1);
    if (IN(2)) { p2_phase(F, A); } SEAM(2);
    if (IN(3)) { p3_phase(F, A); } SEAM(3);
    if (IN(4)) { p4_phase(F, A); } SEAM(4);
    if (IN(5)) {
        pg8::Gemm g{OBB(bf16, OB_MIX) + (size_t)ROW0 * DM, WSB(bf16, WS_WO), M2, DM, DM}; pg8::StaticOrder S; S.init(M2, DM, F.G, F.bid);
        pg8::EpiResF32 E{WSB(float, WS_Z1), DM, WSB(bf16, WS_H) + (size_t)ROW0 * DM, DM, DEEP_ALPHA};
        pg8::gemm_phase<pg8::EpiResF32, pg8::StaticOrder, true, true>(F.lds, g, S, E);
    } SEAM(5);
    if (IN(6)) { ln_rows(F, WSB(float, WS_Z1), A.in[17], A.in[18], WSB(bf16, WS_H), nullptr); } SEAM(6);
    if (IN(7)) {
        pg8::Gemm g{WSB(bf16, WS_H), WSB(bf16, WS_W1), M2, DFF, DM}; pg8::StaticOrder S; S.init(M2, DFF, F.G, F.bid);
        pg8::EpiBf16<2> E{WSB(bf16, WS_HID), DFF};
        pg8::gemm_phase<pg8::EpiBf16<2>, pg8::StaticOrder, true, true>(F.lds, g, S, E);
    } SEAM(7);
    if (IN(8)) {
        pg8::Gemm g{WSB(bf16, WS_HID), WSB(bf16, WS_W2), M2, DM, DFF}; pg8::StaticOrder S; S.init(M2, DM, F.G, F.bid);
        pg8::EpiResF32 E{A.out + O_Y, DM, WSB(bf16, WS_H), DM, DEEP_ALPHA};
        pg8::gemm_phase<pg8::EpiResF32, pg8::StaticOrder, true, true>(F.lds, g, S, E);
    } SEAM(8);
    if (IN(9)) { ln_rows(F, A.out + O_Y, A.in[21], A.in[22], nullptr, A.out + O_Y); }
#undef IN
#undef SEAM
}

extern "C" void kernel_launch(void* const* d_in, const int* in_sizes, int n_in, void* d_out, int out_size, void* d_ws, size_t ws_size, hipStream_t stream) {
    static int grid = 0;
    if (grid == 0) {
        if (n_in != 23 || out_size != (int)O_END || ws_size < WS_END) { fprintf(stderr, "kernel_launch: unexpected problem (n_in %d, out %d, ws %zu); nothing launched\n", n_in, out_size, ws_size); grid = -1; return; }
        int dev = 0, cus = 0, per_cu = 0;
        if (hipGetDevice(&dev) != hipSuccess || hipDeviceGetAttribute(&cus, hipDeviceAttributeMultiprocessorCount, dev) != hipSuccess) { fprintf(stderr, "kernel_launch: device query failed\n"); grid = -1; return; }
        if (hipFuncSetAttribute((const void*)mk_fwd, hipFuncAttributeMaxDynamicSharedMemorySize, LDS_BYTES) != hipSuccess) { fprintf(stderr, "kernel_launch: hipFuncSetAttribute failed\n"); grid = -1; return; }
        if (hipOccupancyMaxActiveBlocksPerMultiprocessor(&per_cu, (const void*)mk_fwd, NTHR, LDS_BYTES) != hipSuccess || per_cu < 1) fprintf(stderr, "kernel_launch: occupancy query reports %d blocks per CU\n", per_cu);
        (void)hipGetLastError();
        grid = cus;
    }
    if (grid < 0) return;
    (void)hipMemsetAsync((char*)d_ws + WS_CTL, 0, CTL_ZERO_BYTES, stream);
    Args a{};
    for (int i = 0; i < 23; ++i) a.in[i] = (const float*)d_in[i];
    a.out = (float*)d_out; a.ws = (unsigned char*)d_ws;
#ifdef PROBE_PHASE
    if (N_LAUNCHES == 1) { a.ph_lo = 0; a.ph_hi = PROBE_PHASE + 1; a.li = 0; hipLaunchKernelGGL(mk_fwd, dim3(grid), dim3(NTHR), LDS_BYTES, stream, a);
                           a.ph_lo = PROBE_PHASE; a.ph_hi = NPH; a.li = 1; hipLaunchKernelGGL(mk_fwd, dim3(grid), dim3(NTHR), LDS_BYTES, stream, a); }
#else
    if (N_LAUNCHES == 1) { a.ph_lo = 0; a.ph_hi = NPH; a.li = 0; hipLaunchKernelGGL(mk_fwd, dim3(grid), dim3(NTHR), LDS_BYTES, stream, a); }
#endif
    else for (int li = 0; li < NPH; ++li) { a.ph_lo = li; a.ph_hi = li + 1; a.li = li; hipLaunchKernelGGL(mk_fwd, dim3(grid), dim3(NTHR), LDS_BYTES, stream, a); }
    const hipError_t le = hipPeekAtLastError();
    if (le != hipSuccess) fprintf(stderr, "kernel_launch: launch failed: %s\n", hipGetErrorName(le));
}
```
